# Optimizing an MI355X kernel written in HIP

```python
import jax
import jax.numpy as jnp
from jax import lax
import numpy as np

D_MODEL = 1024
BATCH = 8
SEQ = 4096
DEPTH = 2
DEC_BATCH = 16
DEC_SEQ = 16
PAST_LEN = 4096

CHUNK = 64
HEAD_DIM = 64
SB_WIDTH = 3 * D_MODEL // 4
N_SB_HEADS = SB_WIDTH // HEAD_DIM
SB_BLOCK = 128
SB_SCALE = HEAD_DIM ** -0.5
SGU_WIDTH = 3 * D_MODEL // 4
SGU_GROUP_DIM = 64
N_SGU_GROUPS = SGU_WIDTH // SGU_GROUP_DIM
MLP_CHUNK = 128
N_MEM = 256
MEM_WIDTH = D_MODEL // 4
N_MEM_HEADS = MEM_WIDTH // HEAD_DIM
D_FF = -(-8 * D_MODEL // (3 * 256)) * 256
N_A_LAYERS = (DEPTH + 1) // 2
N_B_LAYERS = DEPTH // 2
EPS = 1e-6

kernel_name = "stickbreak_sgu_hybrid_stream_step"


def rmsnorm(x, g):
    xf = x.astype(jnp.float32)
    y = xf * lax.rsqrt(jnp.mean(xf * xf, axis=-1, keepdims=True) + EPS)
    return (y * g.astype(jnp.float32)).astype(x.dtype)


def split_heads(x, n_heads):
    return x.reshape(x.shape[:-1] + (n_heads, HEAD_DIM))


def stick_breaking(q, k, v, q_pos, k_pos):
    z = jnp.einsum('bqhd,bkhd->bhqk', q, k, preferred_element_type=jnp.float32) * SB_SCALE
    causal = k_pos[None, :] < q_pos[:, None]
    log_keep = jnp.where(causal, jax.nn.log_sigmoid(-z), 0.0)
    log_rest = lax.cumsum(log_keep, axis=3, reverse=True) - log_keep
    a = jnp.where(causal, jnp.exp(jax.nn.log_sigmoid(z) + log_rest), 0.0)
    return jnp.einsum('bhqk,bkhd->bqhd', a.astype(v.dtype), v)


def stick_breaking_mixer(h, w_in, cache_k=None, cache_v=None):
    proj = h @ w_in
    q, k, v, q_mem = jnp.split(proj, [SB_WIDTH, 2 * SB_WIDTH, 3 * SB_WIDTH], axis=-1)
    q, k, v = split_heads(q, N_SB_HEADS), split_heads(k, N_SB_HEADS), split_heads(v, N_SB_HEADS)
    t_len = h.shape[1]
    if cache_k is None:
        pos = jnp.arange(t_len)
        outs = []
        for start in range(0, t_len, SB_BLOCK):
            stop = min(start + SB_BLOCK, t_len)
            outs.append(stick_breaking(q[:, start:stop], k[:, :stop], v[:, :stop],
                                       pos[start:stop], pos[:stop]))
        o = jnp.concatenate(outs, axis=1)
    else:
        past = cache_k.shape[1]
        k_all = jnp.concatenate([cache_k, k], axis=1)
        v_all = jnp.concatenate([cache_v, v], axis=1)
        o = stick_breaking(q, k_all, v_all, past + jnp.arange(t_len), jnp.arange(past + t_len))
    return o.reshape(o.shape[:2] + (SB_WIDTH,)), q_mem, k, v


def spatial_gating_mixer(h, w_in, w_sp, b_sp, g_sgu):
    proj = h @ w_in
    u, v, q_mem = jnp.split(proj, [SGU_WIDTH, 2 * SGU_WIDTH], axis=-1)
    u = jax.nn.gelu(u)
    v = rmsnorm(jax.nn.gelu(v), g_sgu)
    bsz, t_len, _ = h.shape
    span = min(t_len, MLP_CHUNK)
    tri = jnp.tril(jnp.ones((span, span), dtype=bool))
    w = jnp.where(tri[None], w_sp[:, :span, :span], 0.0)
    vc = v.reshape(bsz, t_len // span, span, N_SGU_GROUPS, SGU_GROUP_DIM)
    mixed = jnp.einsum('gts,bcsgd->bctgd', w, vc) + b_sp[:, :span].T[None, None, :, :, None]
    o = u * mixed.reshape(bsz, t_len, SGU_WIDTH)
    return o, q_mem, v


def memory_kv(mem, g, w):
    kv = rmsnorm(mem, g) @ w
    k, v = jnp.split(kv, 2, axis=-1)
    return split_heads(k, N_MEM_HEADS), split_heads(v, N_MEM_HEADS)


def memory_attention(q_mem, mem_k, mem_v):
    q = split_heads(q_mem, N_MEM_HEADS)
    s = jnp.einsum('bqhd,bmhd->bhqm', q, mem_k, preferred_element_type=jnp.float32) * SB_SCALE
    p = jax.nn.softmax(s, axis=-1)
    o = jnp.einsum('bhqm,bmhd->bqhd', p.astype(mem_v.dtype), mem_v)
    return o.reshape(o.shape[:2] + (MEM_WIDTH,))


def swiglu(h, w_gate, w_up, w_down):
    return (jax.nn.silu(h @ w_gate) * (h @ w_up)) @ w_down


def setup_inputs(seed: int = 0) -> dict:
    key = jax.random.key(seed)
    ks = jax.random.split(key, 24)
    f32 = jnp.float32
    nrm = lambda k, shape, scale: jax.random.normal(k, shape, f32) * scale
    in_a = 3 * SB_WIDTH + MEM_WIDTH
    in_b = 2 * SGU_WIDTH + MEM_WIDTH
    mix_w = SB_WIDTH + MEM_WIDTH
    return {
        "x_prompt": nrm(ks[0], (BATCH, SEQ, D_MODEL), 1.0),
        "x_sample": nrm(ks[1], (DEC_BATCH, DEC_SEQ, D_MODEL), 1.0),
        "cache_sb_k": nrm(ks[2], (N_A_LAYERS, DEC_BATCH, PAST_LEN, N_SB_HEADS, HEAD_DIM), 1.0),
        "cache_sb_v": nrm(ks[3], (N_A_LAYERS, DEC_BATCH, PAST_LEN, N_SB_HEADS, HEAD_DIM), 1.0),
        "cache_mem_k": nrm(ks[4], (DEPTH, DEC_BATCH, N_MEM, N_MEM_HEADS, HEAD_DIM), 1.0),
        "cache_mem_v": nrm(ks[5], (DEPTH, DEC_BATCH, N_MEM, N_MEM_HEADS, HEAD_DIM), 1.0),
        "mem_prompt": nrm(ks[6], (BATCH, N_MEM, D_MODEL), 1.0),
        "g_mix": 1.0 + nrm(ks[7], (DEPTH, D_MODEL), 0.02),
        "w_in_a": nrm(ks[8], (N_A_LAYERS, D_MODEL, in_a), D_MODEL ** -0.5),
        "w_in_b": nrm(ks[9], (N_B_LAYERS, D_MODEL, in_b), D_MODEL ** -0.5),
        "w_sp": nrm(ks[10], (N_B_LAYERS, N_SGU_GROUPS, MLP_CHUNK, MLP_CHUNK), MLP_CHUNK ** -0.5),
        "b_sp": 1.0 + nrm(ks[11], (N_B_LAYERS, N_SGU_GROUPS, MLP_CHUNK), 0.02),
        "g_sgu": 1.0 + nrm(ks[12], (N_B_LAYERS, SGU_WIDTH), 0.02),
        "g_mem": 1.0 + nrm(ks[13], (DEPTH, D_MODEL), 0.02),
        "w_mem_kv": nrm(ks[14], (DEPTH, D_MODEL, 2 * MEM_WIDTH), D_MODEL ** -0.5),
        "w_out": nrm(ks[15], (DEPTH, mix_w, D_MODEL), mix_w ** -0.5),
        "g_ffn": 1.0 + nrm(ks[16], (DEPTH, D_MODEL), 0.02),
        "w_gate": nrm(ks[17], (DEPTH, D_MODEL, D_FF), D_MODEL ** -0.5),
        "w_up": nrm(ks[18], (DEPTH, D_MODEL, D_FF), D_MODEL ** -0.5),
        "w_down": nrm(ks[19], (DEPTH, D_FF, D_MODEL), D_FF ** -0.5),
        "g_final": 1.0 + nrm(ks[20], (D_MODEL,), 0.02),
    }


def reference(x_prompt, x_sample, cache_sb_k, cache_sb_v, cache_mem_k, cache_mem_v,
              mem_prompt, g_mix, w_in_a, w_in_b, w_sp, b_sp, g_sgu, g_mem, w_mem_kv,
              w_out, g_ffn, w_gate, w_up, w_down, g_final):
    y_p, y_s = x_prompt, x_sample
    sb_k_p, sb_v_p, sb_k_s, sb_v_s = [], [], [], []
    mem_k_p, mem_v_p, sgu_v_s = [], [], []
    for l in range(DEPTH):
        mk_p, mv_p = memory_kv(mem_prompt, g_mem[l], w_mem_kv[l])
        mem_k_p.append(mk_p)
        mem_v_p.append(mv_p)
        h_p = rmsnorm(y_p, g_mix[l])
        h_s = rmsnorm(y_s, g_mix[l])
        if l % 2 == 0:
            ia = l // 2
            o_p, qm_p, k_p, v_p = stick_breaking_mixer(h_p, w_in_a[ia])
            o_s, qm_s, k_s, v_s = stick_breaking_mixer(h_s, w_in_a[ia], cache_sb_k[ia], cache_sb_v[ia])
            sb_k_p.append(k_p)
            sb_v_p.append(v_p)
            sb_k_s.append(k_s)
            sb_v_s.append(v_s)
        else:
            ib = l // 2
            o_p, qm_p, _ = spatial_gating_mixer(h_p, w_in_b[ib], w_sp[ib], b_sp[ib], g_sgu[ib])
            o_s, qm_s, vrows_s = spatial_gating_mixer(h_s, w_in_b[ib], w_sp[ib], b_sp[ib], g_sgu[ib])
            sgu_v_s.append(vrows_s)
        m_p = memory_attention(qm_p, mk_p, mv_p)
        m_s = memory_attention(qm_s, cache_mem_k[l], cache_mem_v[l])
        y_p = y_p + jnp.concatenate([o_p, m_p], axis=-1) @ w_out[l]
        y_s = y_s + jnp.concatenate([o_s, m_s], axis=-1) @ w_out[l]
        y_p = y_p + swiglu(rmsnorm(y_p, g_ffn[l]), w_gate[l], w_up[l], w_down[l])
        y_s = y_s + swiglu(rmsnorm(y_s, g_ffn[l]), w_gate[l], w_up[l], w_down[l])
    y_prompt = rmsnorm(y_p, g_final)
    y_sample = rmsnorm(y_s, g_final)
    sb_k_prompt = jnp.stack(sb_k_p)
    sb_v_prompt = jnp.stack(sb_v_p)
    sb_k_sample = jnp.stack(sb_k_s)
    sb_v_sample = jnp.stack(sb_v_s)
    mem_k_prompt = jnp.stack(mem_k_p)
    mem_v_prompt = jnp.stack(mem_v_p)
    sgu_v_sample = jnp.stack(sgu_v_s)
    return (y_prompt, y_sample, sb_k_prompt, sb_v_prompt, sb_k_sample, sb_v_sample,
            mem_k_prompt, mem_v_prompt, sgu_v_sample)
```

```cpp
#include <hip/hip_runtime.h>
#include <hip/hip_bf16.h>
#include <cstdio>
#include <cstdint>
#include <cmath>
namespace pg8 {
#define PG8_LAS __attribute__((address_space(3)))
typedef unsigned short bf16_t;
typedef short bf16x8 __attribute__((ext_vector_type(8)));
typedef float f32x4 __attribute__((ext_vector_type(4)));
typedef unsigned u32x4 __attribute__((ext_vector_type(4)));
constexpr int BM = 256, BK = 64, HALF = 128, HTB = HALF * BK * 2  , STAGE_BYTES = 8 * HTB, NXCD = 8, WGM = 8;

__host__ __device__ __forceinline__ int lds_byte(int r, int c) { const int st = (r >> 4) * 2 + (c >> 5), rr = r & 15, cc = c & 31, ob = rr * 64 + cc * 2; return st * 1024 + (ob ^ (((ob >> 9) & 1) << 5)); }
__host__ __device__ __forceinline__ void stage_rc(int b, int& R, int& C) { const int st = b / 1024, sb = b % 1024, swz = sb ^ (((sb >> 9) & 1) << 5); R = (st >> 1) * 16 + swz / 64; C = (st & 1) * 32 + (swz % 64) / 2; }
__host__ __device__ __forceinline__ int perm32(int rho) { const int n = rho >> 4, i = rho & 15; return 8 * (i >> 2) + 4 * n + (i & 3); }

struct Unit { int pm, pn; };
struct Gemm { const bf16_t* A; const bf16_t* Bt; int M, N, K; };

struct StaticOrder {
    int nM, nN, nwg, G, c;
    __host__ __device__ void init(int M, int N, int G_, int c_) { nM = M / BM; nN = N / BM; nwg = nM * nN; G = G_; c = c_; }
    __host__ __device__ bool next(int i, Unit& u) const {
        const long L = (long)i * G + c; if (L >= nwg) return false;
        int wgid = (int)L; { const int q = nwg / NXCD, r = nwg % NXCD, xcd = wgid % NXCD, off = wgid / NXCD; wgid = (xcd < r ? xcd * (q + 1) : r * (q + 1) + (xcd - r) * q) + off; }
        const int nig = WGM * nN, gid = wgid / nig, fm = gid * WGM, gsz = (nM - fm) < WGM ? (nM - fm) : WGM;
        u.pm = fm + ((wgid % nig) % gsz); u.pn = (wgid % nig) / gsz; return true;
    }
    __device__ __forceinline__ void a_ready(const Unit&) const {}
    __device__ __forceinline__ void done(const Unit&) const {}
};
struct LocalOrder {
    int nM, nN, nwg, GS, r, pm0, rot;
    __host__ __device__ void init(int pm0_, int npanels, int N, int GS_, int r_, int rot_ = 0) { pm0 = pm0_; nM = npanels; nN = N / BM; nwg = nM * nN; GS = GS_; r = r_; rot = rot_; }
    __host__ __device__ bool next(int i, Unit& u) const {
        const int L = i * GS + r; if (L >= nwg) return false;
        const int nig = WGM * nN, gid = L / nig, rem = L - gid * nig;
        int pn = rem / WGM + rot; if (pn >= nN) pn -= nN;
        u.pm = pm0 + gid * WGM + (rem % WGM); u.pn = pn; return true;
    }
    __device__ __forceinline__ void a_ready(const Unit&) const {}
    __device__ __forceinline__ void done(const Unit&) const {}
};

typedef float f32x2 __attribute__((ext_vector_type(2)));
typedef __bf16 bf16x2_t __attribute__((ext_vector_type(2)));
__device__ __forceinline__ unsigned cvt_pk_bf16(float lo, float hi) { const f32x2 v = {lo, hi}; const bf16x2_t b = __builtin_convertvector(v, bf16x2_t); return __builtin_bit_cast(unsigned, b); }
__device__ __forceinline__ f32x2 gelu_pk(f32x2 v) {
    const f32x2 av = __builtin_elementwise_abs(v), d = av * 0.2316418882f + 1.0f;
    f32x2 t; t.x = __builtin_amdgcn_rcpf(d.x); t.y = __builtin_amdgcn_rcpf(d.y);
    f32x2 q = t * 0.5307027145f + (-0.7265760135f); q = q * t + 0.7107068705f; q = q * t + (-0.142248368f); q = q * t + 0.127414796f; q = q * t;
    const f32x2 s = (v * v) * (-0.72134752044f);
    f32x2 e; e.x = __builtin_amdgcn_exp2f(s.x); e.y = __builtin_amdgcn_exp2f(s.y);
    const f32x2 m = v * (q * e), r = v - m;
    f32x2 o; o.x = v.x < 0.f ? m.x : r.x; o.y = v.y < 0.f ? m.y : r.y; return o;
}

typedef float f32x2 __attribute__((ext_vector_type(2)));
constexpr int MP = 32768, MTOT = 33024;
constexpr float RMS_EPS = 1e-6f;
__device__ __forceinline__ u32x4 pack8(const f32x4 v0, const f32x4 v1) { u32x4 w; w.x = cvt_pk_bf16(v0[0], v0[1]); w.y = cvt_pk_bf16(v0[2], v0[3]); w.z = cvt_pk_bf16(v1[0], v1[1]); w.w = cvt_pk_bf16(v1[2], v1[3]); return w; }
template <int NP> __device__ __forceinline__ float row_rstd(const float* ss, int row, float inv_n) {
    const f32x4* p = (const f32x4*)(ss + (size_t)row * NP); float s = 0.f;
#pragma unroll
    for (int i = 0; i < NP / 4; ++i) { const f32x4 v = p[i]; s += (v[0] + v[1]) + (v[2] + v[3]); }
    return __builtin_amdgcn_rsqf(s * inv_n + RMS_EPS);
}
__device__ __forceinline__ float fast_sigmoid(float x) { return __builtin_amdgcn_rcpf(1.0f + __builtin_amdgcn_exp2f(-1.4426950408889634f * x)); }
__device__ __forceinline__ float gelu_tanh(float x) { const float y = 0.7978845608028654f * (x + 0.044715f * x * x * x); return x * fast_sigmoid(2.0f * y); }

struct RstdCache {
    PG8_LAS float* slice; const float* ss;
    __device__ __forceinline__ void prepare(int pm, int wr, int lane) const {
        PG8_LAS int* tag = (PG8_LAS int*)(slice + 128);
        if (__builtin_amdgcn_readfirstlane(*tag) == pm) return;
        f32x4 v[2][4];
#pragma unroll
        for (int k = 0; k < 2; ++k) { const int idx = lane + 64 * k, row = pm * BM + (idx >> 6) * HALF + wr * 64 + (idx & 63); const f32x4* p = (const f32x4*)(ss + (size_t)row * 16);
#pragma unroll
            for (int i = 0; i < 4; ++i) v[k][i] = p[i]; }
#pragma unroll
        for (int k = 0; k < 2; ++k) { float s = 0.f;
#pragma unroll
            for (int i = 0; i < 4; ++i) s += (v[k][i][0] + v[k][i][1]) + (v[k][i][2] + v[k][i][3]);
            slice[lane + 64 * k] = __builtin_amdgcn_rsqf(s * (1.0f / 1024.0f) + RMS_EPS); }
        *tag = pm;
    }
    __device__ __forceinline__ float get(int ai, int m, int fr) const { return slice[ai * 64 + m * 16 + fr]; }
};
struct EpiInA {
    static constexpr bool PERM = true, AFTER_DRAIN = false;
    RstdCache rc; bf16_t *Q, *QM; size_t qkv_stride; float *kout_p, *vout_p;
    __device__ __forceinline__ void operator()(const f32x4 (&acc)[2][2][4][2], const Unit& u, int wr, int wc, int fr, int fq) const {
        const int t = u.pn / 3, colt = (u.pn - 3 * t) * BM + wc * 32 + 8 * fq;
        bf16_t* dst = t == 3 ? QM : Q + (size_t)t * qkv_stride; const int ld = t == 3 ? 256 : 768;
        float* fo = t == 1 ? kout_p : vout_p;
        const bool wf = (t == 1 || t == 2);
        rc.prepare(u.pm, wr, fq * 16 + fr);
#pragma unroll
        for (int ai = 0; ai < 2; ++ai)
#pragma unroll
            for (int m = 0; m < 4; ++m) { const int row = u.pm * BM + ai * HALF + wr * 64 + m * 16 + fr; const float rs = rc.get(ai, m, fr);
#pragma unroll
                for (int bj = 0; bj < 2; ++bj) { const f32x4 v0 = acc[ai][bj][m][0] * rs, v1 = acc[ai][bj][m][1] * rs; const int col = colt + bj * HALF;
                    *(u32x4*)(dst + (size_t)row * ld + col) = pack8(v0, v1);
                    if (wf) {
                        f32x4 A, B;
#pragma unroll
                        for (int c = 0; c < 4; ++c) { const auto s1 = __builtin_amdgcn_permlane16_swap(__float_as_uint(v0[c]), __float_as_uint(v1[c]), false, false);
                            const auto s2 = __builtin_amdgcn_permlane32_swap(s1[0], s1[1], false, false); A[c] = __uint_as_float(s2[0]); B[c] = __uint_as_float(s2[1]); }
                        float* f = fo + (size_t)row * 768 + (col - 8 * fq) + 4 * fq; __builtin_nontemporal_store(A, (f32x4*)f); __builtin_nontemporal_store(B, (f32x4*)(f + 16)); } } }
    }
};
template <bool BASE_F32, bool OUT_F32> struct EpiResidT {
    static constexpr bool PERM = true, AFTER_DRAIN = false;
    const void* base; void* out; float* ss;
    __device__ __forceinline__ void operator()(const f32x4 (&acc)[2][2][4][2], const Unit& u, int wr, int wc, int fr, int fq) const {
        const int col0 = u.pn * BM + wc * 32 + 8 * fq;
#pragma unroll
        for (int ai = 0; ai < 2; ++ai) {
            f32x4 b[4][2][2];
#pragma unroll
            for (int m = 0; m < 4; ++m) { const size_t off = (size_t)(u.pm * BM + ai * HALF + wr * 64 + m * 16 + fr) * 1024 + col0;
#pragma unroll
                for (int bj = 0; bj < 2; ++bj) {
                    if (BASE_F32) { b[m][bj][0] = *(const f32x4*)((const float*)base + off + bj * HALF); b[m][bj][1] = *(const f32x4*)((const float*)base + off + bj * HALF + 4); }
                    else { const u32x4 r = *(const u32x4*)((const bf16_t*)base + off + bj * HALF);
                        b[m][bj][0] = (f32x4){__uint_as_float(r.x << 16), __uint_as_float(r.x & 0xffff0000u), __uint_as_float(r.y << 16), __uint_as_float(r.y & 0xffff0000u)};
                        b[m][bj][1] = (f32x4){__uint_as_float(r.z << 16), __uint_as_float(r.z & 0xffff0000u), __uint_as_float(r.w << 16), __uint_as_float(r.w & 0xffff0000u)}; } } }
            asm volatile("" ::: "memory");
#pragma unroll
            for (int m = 0; m < 4; ++m) { const int row = u.pm * BM + ai * HALF + wr * 64 + m * 16 + fr; const size_t off = (size_t)row * 1024 + col0; f32x2 q2 = {0.f, 0.f};
#pragma unroll
                for (int bj = 0; bj < 2; ++bj) { const f32x4 v0 = acc[ai][bj][m][0] + b[m][bj][0], v1 = acc[ai][bj][m][1] + b[m][bj][1];
                    if (OUT_F32) { *(f32x4*)((float*)out + off + bj * HALF) = v0; *(f32x4*)((float*)out + off + bj * HALF + 4) = v1; }
                    else *(u32x4*)((bf16_t*)out + off + bj * HALF) = pack8(v0, v1);
                    const f32x2 p0 = {v0[0], v0[1]}, p1 = {v0[2], v0[3]}, p2 = {v1[0], v1[1]}, p3 = {v1[2], v1[3]};
                    q2 = p0 * p0 + q2; q2 = p1 * p1 + q2; q2 = p2 * p2 + q2; q2 = p3 * p3 + q2; }
                float s = q2.x + q2.y;
                s += __shfl_xor(s, 16); s += __shfl_xor(s, 32);
                if (fq == 0) ss[(size_t)row * 16 + u.pn * 4 + wc] = s; }
        }
    }
};
struct EpiGateUp {
    static constexpr bool PERM = true, AFTER_DRAIN = false;
    RstdCache rc; bf16_t* H;
    __device__ __forceinline__ void operator()(const f32x4 (&acc)[2][2][4][2], const Unit& u, int wr, int wc, int fr, int fq) const {
        const int col = u.pn * HALF + wc * 32 + 8 * fq;
        rc.prepare(u.pm, wr, fq * 16 + fr);
#pragma unroll
        for (int ai = 0; ai < 2; ++ai)
#pragma unroll
            for (int m = 0; m < 4; ++m) { const int row = u.pm * BM + ai * HALF + wr * 64 + m * 16 + fr; const float rs = rc.get(ai, m, fr), c1 = -1.4426950408889634f * rs, c2 = rs * rs;
                u32x4 w;
#pragma unroll
                for (int n = 0; n < 2; ++n)
#pragma unroll
                    for (int p = 0; p < 2; ++p) { const f32x2 g = {acc[ai][0][m][n][2 * p], acc[ai][0][m][n][2 * p + 1]}, up = {acc[ai][1][m][n][2 * p], acc[ai][1][m][n][2 * p + 1]};
                        const f32x2 t = g * c1; f32x2 e; e.x = __builtin_amdgcn_exp2f(t.x); e.y = __builtin_amdgcn_exp2f(t.y);
                        const f32x2 d = e + 1.0f; f32x2 r; r.x = __builtin_amdgcn_rcpf(d.x); r.y = __builtin_amdgcn_rcpf(d.y);
                        const f32x2 h = ((g * up) * c2) * r;
                        w[2 * n + p] = cvt_pk_bf16(h.x, h.y); }
                *(u32x4*)(H + (size_t)row * 2816 + col) = w; }
    }
};
struct EpiInB {
    static constexpr bool PERM = true, AFTER_DRAIN = false;
    RstdCache rc; bf16_t *U, *QM; size_t ugv_stride; float* ssv;
    __device__ __forceinline__ void operator()(const f32x4 (&acc)[2][2][4][2], const Unit& u, int wr, int wc, int fr, int fq) const {
        const int t = u.pn / 3, pl = u.pn - 3 * t, colt = pl * BM + wc * 32 + 8 * fq;
        bf16_t* dst = t == 2 ? QM : U + (size_t)t * ugv_stride; const int ld = t == 2 ? 256 : 768;
        rc.prepare(u.pm, wr, fq * 16 + fr);
#pragma unroll
        for (int ai = 0; ai < 2; ++ai)
#pragma unroll
            for (int m = 0; m < 4; ++m) { const int row = u.pm * BM + ai * HALF + wr * 64 + m * 16 + fr; const float rs = rc.get(ai, m, fr); float s = 0.f;
#pragma unroll
                for (int bj = 0; bj < 2; ++bj) { f32x4 v0 = acc[ai][bj][m][0] * rs, v1 = acc[ai][bj][m][1] * rs;
                    if (t < 2) {
                        f32x2 q2 = {0.f, 0.f};
#pragma unroll
                        for (int p = 0; p < 4; ++p) { f32x2 x; if (p < 2) { x.x = v0[2 * p]; x.y = v0[2 * p + 1]; } else { x.x = v1[2 * p - 4]; x.y = v1[2 * p - 3]; }
                            const f32x2 a = x * ((x * x) * (-0.10294324f) + (-2.3022082f)); f32x2 e; e.x = __builtin_amdgcn_exp2f(a.x); e.y = __builtin_amdgcn_exp2f(a.y);
                            const f32x2 d = e + 1.0f; f32x2 r; r.x = __builtin_amdgcn_rcpf(d.x); r.y = __builtin_amdgcn_rcpf(d.y);
                            const f32x2 y = x * r; q2 = y * y + q2;
                            if (p < 2) { v0[2 * p] = y.x; v0[2 * p + 1] = y.y; } else { v1[2 * p - 4] = y.x; v1[2 * p - 3] = y.y; } }
                        s += q2.x + q2.y; }
                    *(u32x4*)(dst + (size_t)row * ld + colt + bj * HALF) = pack8(v0, v1); }
                if (t == 1) { s += __shfl_xor(s, 16); s += __shfl_xor(s, 32); if (fq == 0) ssv[(size_t)row * 12 + pl * 4 + wc] = s; } }
    }
};
template <class Epi, class Sched, bool ALIGN_EPI = false, bool SP2 = false>
__device__ __forceinline__ void gemm_phase(PG8_LAS unsigned char* lds, const Gemm g, const Sched& S, const Epi& E) {
    int tid = threadIdx.x; asm volatile("" : "+v"(tid));
    const int wid = __builtin_amdgcn_readfirstlane(tid >> 6), lane = tid & 63, wr = wid >> 2, wc = wid & 3, fr = lane & 15, fq = lane >> 4;
    const int K = g.K, nt = K / BK;
    unsigned voffA[2], voffB[2];
#pragma unroll
    for (int i = 0; i < 2; ++i) { int R, C; stage_rc(tid * 16 + i * 8192, R, C); const int Rb = Epi::PERM ? ((R & ~31) + perm32(R & 31)) : R;
        voffA[i] = (unsigned)(R * K + C) * 2u; voffB[i] = (unsigned)(Rb * K + C) * 2u; }
    const size_t kstep = (size_t)(BK * 2);
    const size_t hstep = (size_t)HALF * K * 2;
    const size_t tstep = 2 * hstep;
    const unsigned ldsw = (unsigned)wid * 1024u;
    const int aoff = lds_byte(wr * 64 + fr, fq * 8), boff = lds_byte(wc * 32 + fr, fq * 8);
#define PG8_SA(b, h) (((b) * 2 + (h)) * HTB)
#define PG8_SB(b, h) ((4 + (b) * 2 + (h)) * HTB)
#define PG8_STAGE(bufoff, gbase, voff) do { _Pragma("unroll") for (int _i = 0; _i < 2; ++_i) \
        __builtin_amdgcn_global_load_lds((const unsigned*)((const char*)(gbase) + (voff)[_i]), (PG8_LAS unsigned*)(lds + (bufoff) + ldsw + _i * 8192), 16, 0, 0); } while (0)
#define PG8_LDA(dst, b, h) do { _Pragma("unroll") for (int m = 0; m < 4; ++m) _Pragma("unroll") for (int k = 0; k < 2; ++k) dst[m][k] = *(const PG8_LAS bf16x8*)(lds + PG8_SA(b, h) + aoff + m * 2048 + k * 1024); } while (0)
#define PG8_LDB(dst, b, h) do { _Pragma("unroll") for (int n = 0; n < 2; ++n) _Pragma("unroll") for (int k = 0; k < 2; ++k) dst[n][k] = *(const PG8_LAS bf16x8*)(lds + PG8_SB(b, h) + boff + n * 2048 + k * 1024); } while (0)
#define PG8_MMA(ai, bj, At, Bt) do { __builtin_amdgcn_s_setprio(1); _Pragma("unroll") for (int m = 0; m < 4; ++m) _Pragma("unroll") for (int n = 0; n < 2; ++n) _Pragma("unroll") for (int k = 0; k < 2; ++k) \
        acc[ai][bj][m][n] = __builtin_amdgcn_mfma_f32_16x16x32_bf16(Bt[n][k], At[m][k], acc[ai][bj][m][n], 0, 0, 0); __builtin_amdgcn_s_setprio(0); } while (0)
#define PG8_WAIT_V(n) asm volatile("s_waitcnt vmcnt(" #n ")" ::: "memory")
#define PG8_WAIT_L(n) asm volatile("s_waitcnt lgkmcnt(" #n ")" ::: "memory")
#define PG8_BAR __builtin_amdgcn_s_barrier()
#define PG8_SCHED __builtin_amdgcn_sched_barrier(0)
    Unit cur, nxt; int ui = 0;
    if (!S.next(0, cur)) return;
    f32x4 acc[2][2][4][2];
#pragma unroll
    for (int a = 0; a < 2; ++a)
#pragma unroll
        for (int b = 0; b < 2; ++b)
#pragma unroll
            for (int m = 0; m < 4; ++m)
#pragma unroll
                for (int n = 0; n < 2; ++n) acc[a][b][m][n] = (f32x4){0.f, 0.f, 0.f, 0.f};
    bf16x8 At[4][2], B0[2][2], B1[2][2];
    const char* cA = (const char*)g.A + (size_t)cur.pm * tstep; const char* cB = (const char*)g.Bt + (size_t)cur.pn * tstep;
    S.a_ready(cur);
    if constexpr (SP2) {
        PG8_STAGE(PG8_SB(0, 0), cB, voffB); PG8_STAGE(PG8_SB(0, 1), cB + hstep, voffB); PG8_STAGE(PG8_SA(0, 0), cA, voffA); PG8_STAGE(PG8_SA(0, 1), cA + hstep, voffA);
        if (wr == 1) PG8_BAR;
        PG8_WAIT_V(2); PG8_BAR;
        PG8_STAGE(PG8_SB(1, 0), cB + kstep, voffB); PG8_STAGE(PG8_SA(1, 0), cA + kstep, voffA); PG8_STAGE(PG8_SB(1, 1), cB + hstep + kstep, voffB);
        PG8_WAIT_V(6); PG8_BAR;
    } else {
        PG8_STAGE(PG8_SB(0, 0), cB, voffB); PG8_STAGE(PG8_SA(0, 0), cA, voffA); PG8_STAGE(PG8_SB(0, 1), cB + hstep, voffB); PG8_STAGE(PG8_SA(0, 1), cA + hstep, voffA);
        if (wr == 1) PG8_BAR;
        PG8_WAIT_V(4); PG8_BAR;
        PG8_STAGE(PG8_SB(1, 0), cB + kstep, voffB); PG8_STAGE(PG8_SA(1, 0), cA + kstep, voffA); PG8_STAGE(PG8_SB(1, 1), cB + hstep + kstep, voffB);
        PG8_WAIT_V(6); PG8_BAR;
    }
    for (;;) {
        const bool has_next = S.next(ui + 1, nxt);
        const char* nA = has_next ? (const char*)g.A + (size_t)nxt.pm * tstep : cA; const char* nB = has_next ? (const char*)g.Bt + (size_t)nxt.pn * tstep : cB;
        for (int t = 0; t < nt; t += 2) {
            const bool last = (t == nt - 2);
            const char* a1 = cA + (size_t)(t + 1) * kstep;
            const char* a2 = last ? nA : cA + (size_t)(t + 2) * kstep; const char* b2 = last ? nB : cB + (size_t)(t + 2) * kstep;
            const char* a3 = a2 + kstep; const char* b3 = b2 + kstep;
            if (last && has_next) S.a_ready(nxt);
            if constexpr (SP2) {
            PG8_LDB(B0, 0, 0); PG8_LDB(B1, 0, 1); PG8_SCHED; PG8_LDA(At, 0, 0); PG8_STAGE(PG8_SA(1, 1), a1 + hstep, voffA);
            PG8_WAIT_V(8); PG8_WAIT_L(0); PG8_BAR; PG8_MMA(0, 0, At, B0); PG8_MMA(0, 1, At, B1); PG8_BAR; PG8_SCHED;
            PG8_LDA(At, 0, 1); PG8_STAGE(PG8_SB(0, 0), b2, voffB); PG8_STAGE(PG8_SB(0, 1), b2 + hstep, voffB); PG8_STAGE(PG8_SA(0, 0), a2, voffA);
            PG8_WAIT_V(8); PG8_WAIT_L(0); PG8_BAR; PG8_MMA(1, 0, At, B0); PG8_MMA(1, 1, At, B1); PG8_BAR; PG8_SCHED;
            PG8_LDB(B0, 1, 0); PG8_LDB(B1, 1, 1); PG8_SCHED; PG8_LDA(At, 1, 0); PG8_STAGE(PG8_SA(0, 1), a2 + hstep, voffA);
            PG8_WAIT_V(8); PG8_WAIT_L(0); PG8_BAR; PG8_MMA(0, 0, At, B0); PG8_MMA(0, 1, At, B1); PG8_BAR; PG8_SCHED;
            PG8_LDA(At, 1, 1); PG8_STAGE(PG8_SB(1, 0), b3, voffB); PG8_STAGE(PG8_SB(1, 1), b3 + hstep, voffB); PG8_STAGE(PG8_SA(1, 0), a3, voffA);
            PG8_WAIT_V(8); PG8_WAIT_L(0); PG8_BAR; PG8_MMA(1, 0, At, B0); PG8_MMA(1, 1, At, B1); PG8_BAR; PG8_SCHED;
            } else {
            PG8_LDB(B0, 0, 0); PG8_SCHED; PG8_LDA(At, 0, 0); PG8_STAGE(PG8_SA(1, 1), a1 + hstep, voffA);
            PG8_WAIT_L(8); PG8_BAR; PG8_WAIT_L(0); PG8_MMA(0, 0, At, B0); PG8_BAR; PG8_SCHED;
            PG8_LDB(B1, 0, 1); PG8_STAGE(PG8_SB(0, 0), b2, voffB);
            PG8_BAR; PG8_WAIT_L(0); PG8_MMA(0, 1, At, B1); PG8_BAR;
            PG8_LDA(At, 0, 1); PG8_STAGE(PG8_SA(0, 0), a2, voffA);
            PG8_BAR; PG8_WAIT_L(0); PG8_MMA(1, 0, At, B0); PG8_BAR; PG8_SCHED;
            PG8_STAGE(PG8_SB(0, 1), b2 + hstep, voffB);
            PG8_WAIT_V(6); PG8_BAR; PG8_MMA(1, 1, At, B1); PG8_BAR;
            PG8_LDB(B0, 1, 0); PG8_SCHED; PG8_LDA(At, 1, 0); PG8_STAGE(PG8_SA(0, 1), a2 + hstep, voffA);
            PG8_WAIT_L(8); PG8_BAR; PG8_WAIT_L(0); PG8_MMA(0, 0, At, B0); PG8_BAR; PG8_SCHED;
            PG8_LDB(B1, 1, 1); PG8_STAGE(PG8_SB(1, 0), b3, voffB);
            PG8_BAR; PG8_WAIT_L(0); PG8_MMA(0, 1, At, B1); PG8_BAR;
            PG8_LDA(At, 1, 1); PG8_STAGE(PG8_SA(1, 0), a3, voffA);
            PG8_BAR; PG8_WAIT_L(0); PG8_MMA(1, 0, At, B0); PG8_BAR; PG8_SCHED;
            PG8_STAGE(PG8_SB(1, 1), b3 + hstep, voffB);
            PG8_WAIT_V(6); PG8_BAR; PG8_MMA(1, 1, At, B1); PG8_BAR;
            }
        }
        if constexpr (ALIGN_EPI) { if (wr == 0) PG8_BAR; }
        if constexpr (!Epi::AFTER_DRAIN) { E(acc, cur, wr, wc, fr, fq); S.done(cur); }
        if (!has_next) break;
#pragma unroll
        for (int a = 0; a < 2; ++a)
#pragma unroll
            for (int b = 0; b < 2; ++b)
#pragma unroll
                for (int m = 0; m < 4; ++m)
#pragma unroll
                    for (int n = 0; n < 2; ++n) acc[a][b][m][n] = (f32x4){0.f, 0.f, 0.f, 0.f};
        cur = nxt; cA = nA; cB = nB; ++ui;
        if constexpr (ALIGN_EPI) { if (wr == 1) PG8_BAR; }
    }
    PG8_WAIT_V(0);
    if constexpr (!ALIGN_EPI) { if (wr == 0) PG8_BAR; }
    PG8_BAR;
    if constexpr (Epi::AFTER_DRAIN) { E.fused(acc, cur, wr, wc, fr, fq, lds, wid, lane); S.done(cur); }
#undef PG8_SA
#undef PG8_SB
#undef PG8_STAGE
#undef PG8_LDA
#undef PG8_LDB
#undef PG8_MMA
#undef PG8_WAIT_V
#undef PG8_WAIT_L
#undef PG8_BAR
#undef PG8_SCHED
}
}
namespace mx {
#define MX_LAS __attribute__((address_space(3)))
typedef unsigned short bf16_t;
typedef short bf16x8 __attribute__((ext_vector_type(8)));
typedef short s16x4 __attribute__((ext_vector_type(4)));
typedef float f32x16 __attribute__((ext_vector_type(16)));
typedef float f32x4 __attribute__((ext_vector_type(4)));
typedef unsigned u32x4 __attribute__((ext_vector_type(4)));
typedef float f32x2_t __attribute__((ext_vector_type(2))); typedef __bf16 bf16x2_t __attribute__((ext_vector_type(2)));
typedef MX_LAS unsigned char* lptr; typedef const MX_LAS unsigned char* lcptr;
#define MX_MFMA(a, b, c) __builtin_amdgcn_mfma_f32_32x32x16_bf16((a), (b), (c), 0, 0, 0)
constexpr int WAVE_LDS = 16384, KIMG = 0, VIMG = 8192;
constexpr float SB_EXIT = 9.0949470177e-13f;
__device__ __forceinline__ int crow(int r, int hi) { return (r & 3) + 8 * (r >> 2) + 4 * hi; }
__device__ __forceinline__ unsigned cvtpk(float lo, float hi) { f32x2_t v = {lo, hi}; bf16x2_t b = __builtin_convertvector(v, bf16x2_t); return __builtin_bit_cast(unsigned, b); }
__device__ __forceinline__ unsigned short f2bf(float f) { return (unsigned short)(cvtpk(f, 0.f) & 0xffffu); }
__device__ __forceinline__ float bf2f(unsigned short h) { return __uint_as_float(((unsigned)h) << 16); }
__device__ __forceinline__ s16x4 vtr(lcptr p) { typedef short v4i16_t __attribute__((ext_vector_type(4))); return __builtin_bit_cast(s16x4, __builtin_amdgcn_ds_read_tr16_b64_v4i16((MX_LAS v4i16_t*)p)); }
__device__ __forceinline__ u32x4 pk8(const f32x4 a, const f32x4 b) { u32x4 w; w.x = cvtpk(a[0], a[1]); w.y = cvtpk(a[2], a[3]); w.z = cvtpk(b[0], b[1]); w.w = cvtpk(b[2], b[3]); return w; }

template <bool DOK, bool DOV> __device__ __forceinline__ void load_tile_bf16(lptr slot, const bf16_t* Kg, const bf16_t* Vg, int pitch, int lane, int nvalid) {
    if (DOK) { const bool ok = lane < nvalid; const bf16_t* kr = Kg + (size_t)(ok ? lane : 0) * pitch; u32x4 kv[8];
#pragma unroll
        for (int c = 0; c < 8; ++c) kv[c] = *(const u32x4*)(kr + c * 8);
#pragma unroll
        for (int c = 0; c < 8; ++c) *(MX_LAS u32x4*)(slot + KIMG + c * 1024 + lane * 16) = ok ? kv[c] : (u32x4){0u, 0u, 0u, 0u}; }
    if (DOV) { u32x4 vv[8];
#pragma unroll
        for (int p = 0; p < 8; ++p) { const int row = 16 * (p & 3) + (lane >> 2); const bool ok = row < nvalid; vv[p] = *(const u32x4*)(Vg + (size_t)(ok ? row : 0) * pitch + (p >> 2) * 32 + (lane & 3) * 8); if (!ok) vv[p] = (u32x4){0u, 0u, 0u, 0u}; }
#pragma unroll
        for (int p = 0; p < 8; ++p) *(MX_LAS u32x4*)(slot + VIMG + p * 1024 + lane * 16) = vv[p]; }
}
__device__ __forceinline__ void load_tile_f32(lptr slot, const float* Kg, const float* Vg, int pitch, int lane) {
    { const float* kr = Kg + (size_t)lane * pitch;
#pragma unroll
        for (int c = 0; c < 8; ++c) { const f32x4 a = *(const f32x4*)(kr + c * 8), b = *(const f32x4*)(kr + c * 8 + 4); *(MX_LAS u32x4*)(slot + KIMG + c * 1024 + lane * 16) = pk8(a, b); } }
#pragma unroll
    for (int p = 0; p < 8; ++p) { const float* vr = Vg + (size_t)(16 * (p & 3) + (lane >> 2)) * pitch + (p >> 2) * 32 + (lane & 3) * 8;
        const f32x4 a = *(const f32x4*)vr, b = *(const f32x4*)(vr + 4); *(MX_LAS u32x4*)(slot + VIMG + p * 1024 + lane * 16) = pk8(a, b); }
}
template <bool SWZ = false> __device__ __forceinline__ void qkt(f32x16& p0, f32x16& p1, lcptr slot, const bf16x8 (&qr)[4], int r32, int hi) {
    f32x16 z;
#pragma unroll
    for (int r = 0; r < 16; ++r) z[r] = 0.f;
    p0 = z; p1 = z;
#pragma unroll
    for (int d0 = 0; d0 < 4; ++d0) { const int c = 2 * d0 + hi; lcptr kb = slot + KIMG + c * 1024 + (SWZ ? ((r32 & 24) | ((r32 ^ c) & 7)) : r32) * 16;
        const bf16x8 b0 = *(const MX_LAS bf16x8*)kb, b1 = *(const MX_LAS bf16x8*)(kb + 512);
        p0 = MX_MFMA(b0, qr[d0], p0); p1 = MX_MFMA(b1, qr[d0], p1); }
}
__device__ __forceinline__ void pv(f32x16 (&o)[2], lcptr slot, const f32x16& p0, const f32x16& p1, int lane, int hi) {
    lcptr vp = slot + VIMG + ((lane >> 4) & 1) * 32 + (lane & 3) * 8 + (4 * hi + ((lane & 15) >> 2)) * 64;
    u32x4 pw[4];
    pw[0] = (u32x4){cvtpk(p0[0], p0[1]), cvtpk(p0[2], p0[3]), cvtpk(p0[4], p0[5]), cvtpk(p0[6], p0[7])};
    pw[1] = (u32x4){cvtpk(p0[8], p0[9]), cvtpk(p0[10], p0[11]), cvtpk(p0[12], p0[13]), cvtpk(p0[14], p0[15])};
    pw[2] = (u32x4){cvtpk(p1[0], p1[1]), cvtpk(p1[2], p1[3]), cvtpk(p1[4], p1[5]), cvtpk(p1[6], p1[7])};
    pw[3] = (u32x4){cvtpk(p1[8], p1[9]), cvtpk(p1[10], p1[11]), cvtpk(p1[12], p1[13]), cvtpk(p1[14], p1[15])};
#pragma unroll
    for (int d0 = 0; d0 < 2; ++d0)
#pragma unroll
        for (int ks = 0; ks < 4; ++ks) { const s16x4 lo = vtr(vp + d0 * 4096 + ks * 1024), hh = vtr(vp + d0 * 4096 + ks * 1024 + 512);
            const bf16x8 vf = (bf16x8){lo[0], lo[1], lo[2], lo[3], hh[0], hh[1], hh[2], hh[3]};
            o[d0] = MX_MFMA(__builtin_bit_cast(bf16x8, pw[ks]), vf, o[d0]); }
}
template <bool MASK> __device__ __forceinline__ void sb_half(f32x16& p, float& S, int hi, int kbase, int qrel) {
    float k[16];
#pragma unroll
    for (int r = 0; r < 16; ++r) { const float z = __builtin_amdgcn_fmed3f(p[r], -126.f, 126.f), e = __builtin_amdgcn_exp2f(-z);   float bt = __builtin_amdgcn_rcpf(1.0f + e), kp = e * bt;
        if (MASK) { if (kbase + crow(r, hi) >= qrel) { bt = 0.f; kp = 1.f; } } p[r] = bt; k[r] = kp; }
    float GE[4], GO[4];
#pragma unroll
    for (int i = 0; i < 4; ++i) { const float g = (k[4 * i] * k[4 * i + 1]) * (k[4 * i + 2] * k[4 * i + 3]);
        auto rr = __builtin_amdgcn_permlane32_swap(__float_as_uint(g), __float_as_uint(g), false, false); GE[i] = __uint_as_float(rr[0]); GO[i] = __uint_as_float(rr[1]); }
    float own[4];
#pragma unroll
    for (int i = 3; i >= 0; --i) { const float So = S; S = S * GO[i]; const float Se = S; S = S * GE[i]; own[i] = hi ? So : Se; }
#pragma unroll
    for (int i = 0; i < 4; ++i) { float rest = own[i]; const float a3 = p[4 * i + 3] * rest; rest *= k[4 * i + 3]; const float a2 = p[4 * i + 2] * rest; rest *= k[4 * i + 2]; const float a1 = p[4 * i + 1] * rest; rest *= k[4 * i + 1];
        const float a0 = p[4 * i] * rest; p[4 * i] = a0; p[4 * i + 1] = a1; p[4 * i + 2] = a2; p[4 * i + 3] = a3; }
}
template <bool MASK, bool SWZ = false> __device__ __forceinline__ void sb_tile(f32x16 (&o)[2], float& carry, lcptr slot, const bf16x8 (&qr)[4], int lane, int r32, int hi, int qrel) {
    f32x16 p0, p1; qkt<SWZ>(p0, p1, slot, qr, r32, hi);
    sb_half<MASK>(p1, carry, hi, 32, qrel);
    sb_half<MASK>(p0, carry, hi, 0, qrel);
    pv(o, slot, p0, p1, lane, hi);
}
__device__ __forceinline__ void store_o(const f32x16 (&o)[2], bf16_t* OM, size_t row0, int col0, int r32, int hi, int nrows) {
#pragma unroll
    for (int r = 0; r < 16; ++r) { const int q = crow(r, hi); if (q < nrows) { bf16_t* p = OM + (row0 + q) * 1024 + col0 + r32; p[0] = f2bf(o[0][r]); p[32] = f2bf(o[1][r]); } }
}
__device__ __forceinline__ void store_o_staged(const f32x16 (&o)[2], lptr stg, bf16_t* OM, size_t row0, int col0, int lane, int nrows) {
    const int r32 = lane & 31, hi = lane >> 5;
#pragma unroll
    for (int r = 0; r < 16; ++r) { const int q = crow(r, hi); *(MX_LAS bf16_t*)(stg + (q * 64 + r32) * 2) = f2bf(o[0][r]); *(MX_LAS bf16_t*)(stg + (q * 64 + 32 + r32) * 2) = f2bf(o[1][r]); }
#pragma unroll
    for (int i = 0; i < 4; ++i) { const int row = i * 8 + (lane >> 3), ch = lane & 7; const u32x4 v = *(const MX_LAS u32x4*)(stg + (row * 64 + ch * 8) * 2);
        if (row < nrows) *(u32x4*)(OM + (row0 + row) * 1024 + col0 + ch * 8) = v;
        asm volatile("" ::: "memory"); }
}
struct SbArgs { const bf16_t *Q, *K, *V; const float *cK, *cV; bf16_t* OM; };
__device__ __forceinline__ void sb_sample_unit(const SbArgs& A, lptr slot, int b, int h, int lane) {
    asm volatile("" : "+v"(lane));
    const int r32 = lane & 31, hi = lane >> 5, qi = r32 & 15; const size_t row0 = (size_t)pg8::MP + b * 16;
    bf16x8 qr[4]; { const bf16_t* qp = A.Q + (row0 + qi) * 768 + h * 64 + hi * 8;
#pragma unroll
        for (int d0 = 0; d0 < 4; ++d0) qr[d0] = *(const bf16x8*)(qp + d0 * 16); }
    f32x16 o[2];
#pragma unroll
    for (int r = 0; r < 16; ++r) { o[0][r] = 0.f; o[1][r] = 0.f; }
    float carry = 1.0f;
    { const size_t toff = row0 * 768 + h * 64; load_tile_bf16<true, true>(slot, A.K + toff, A.V + toff, 768, lane, 16);
      sb_tile<true>(o, carry, slot, qr, lane, r32, hi, qi); }
    for (int T = 63; T >= 0; --T) {
        if (__all(carry < SB_EXIT)) break;
        const size_t toff = ((size_t)b * 4096 + 64 * T) * 768 + h * 64;
        load_tile_f32(slot, A.cK + toff, A.cV + toff, 768, lane);
        sb_tile<false>(o, carry, slot, qr, lane, r32, hi, 0);
    }
    store_o(o, A.OM, row0, h * 64, r32, hi, 16);
}
constexpr int SB_WIN = 5;
struct SbPre { u32x4 k[SB_WIN], v[SB_WIN]; };
__device__ __forceinline__ void sb_prefetch(SbPre& P, const SbArgs& A, int u, int tid) {
    const int bh = u >> 4, qb = u & 15, b = bh / 12, h = bh - 12 * b, Tlo = qb == 0 ? 0 : 4 * qb - (SB_WIN - 4), nt = qb == 0 ? 4 : SB_WIN;
    const size_t base = ((size_t)b * 4096 + (tid >> 3)) * 768 + h * 64 + (tid & 7) * 8;
#pragma unroll
    for (int s = 0; s < SB_WIN; ++s) { const int T = Tlo + (s < nt ? s : nt - 1); const size_t off = base + (size_t)T * 64 * 768; P.k[s] = *(const u32x4*)(A.K + off); P.v[s] = *(const u32x4*)(A.V + off); }
}
__device__ __forceinline__ void sb_stage_piece(lptr slot, const u32x4 kk, const u32x4 vv, int tid) {
    const int row = tid >> 3, c = tid & 7;
    *(MX_LAS u32x4*)(slot + KIMG + c * 1024 + ((row & 56) | ((row ^ c) & 7)) * 16) = kk;
    *(MX_LAS u32x4*)(slot + VIMG + (c >> 2) * 4096 + row * 64 + (c & 3) * 16) = vv;
}
__device__ __forceinline__ void sb_wg_units(const SbArgs& A, lptr lds, int u0, int u1, int tid) {
    asm volatile("" : "+v"(tid));
    const int lane = tid & 63, wave = __builtin_amdgcn_readfirstlane(tid >> 6), r32 = lane & 31, hi = lane >> 5;
    if (u0 >= u1) return;
    MX_LAS unsigned* flags = (MX_LAS unsigned*)(lds + SB_WIN * WAVE_LDS);
    SbPre P; sb_prefetch(P, A, u0, tid);
    for (int u = u0; u < u1; ++u) {
        const int bh = u >> 4, qb = u & 15, b = bh / 12, h = bh - 12 * b, Tlo = qb == 0 ? 0 : 4 * qb - (SB_WIN - 4);
        __syncthreads();
#pragma unroll
        for (int s = 0; s < SB_WIN; ++s) sb_stage_piece(lds + s * WAVE_LDS, P.k[s], P.v[s], tid);
        __syncthreads();
        const size_t rowq = (size_t)b * 4096 + 256 * qb + 32 * wave;
        bf16x8 qr[4]; { const bf16_t* qp = A.Q + (rowq + r32) * 768 + h * 64 + hi * 8;
#pragma unroll
            for (int d0 = 0; d0 < 4; ++d0) qr[d0] = *(const bf16x8*)(qp + d0 * 16); }
        asm volatile("" ::: "memory");
        sb_prefetch(P, A, u + 1 < u1 ? u + 1 : u, tid);
        f32x16 o[2];
#pragma unroll
        for (int r = 0; r < 16; ++r) { o[0][r] = 0.f; o[1][r] = 0.f; }
        float carry = 1.0f; const int Td = 4 * qb + (wave >> 1); bool done = false;
        for (int T = Td; T >= Tlo; --T) {
            lcptr slot = lds + (T - Tlo) * WAVE_LDS;
            if (T == Td) sb_tile<true, true>(o, carry, slot, qr, lane, r32, hi, 32 * (wave & 1) + r32); else sb_tile<false, true>(o, carry, slot, qr, lane, r32, hi, 0);
            if (__all(carry < SB_EXIT)) { done = true; break; }
        }
        for (int T = Tlo - 1; ; --T) {
            const bool need = !done && T >= 0;
            if (lane == 0) flags[wave] = need ? 1u : 0u;
            __syncthreads();
            unsigned any = 0u;
#pragma unroll
            for (int w = 0; w < 8; ++w) any |= flags[w];
            if (!__builtin_amdgcn_readfirstlane(any)) break;
            { const size_t off = ((size_t)b * 4096 + (size_t)T * 64 + (tid >> 3)) * 768 + h * 64 + (tid & 7) * 8; sb_stage_piece(lds, *(const u32x4*)(A.K + off), *(const u32x4*)(A.V + off), tid); }
            __syncthreads();
            if (need) { sb_tile<false, true>(o, carry, lds, qr, lane, r32, hi, 0); if (__all(carry < SB_EXIT)) done = true; }
        }
        store_o(o, A.OM, rowq, h * 64, r32, hi, 32);
    }
    __syncthreads();
}
struct MaArgs { const bf16_t *QM, *MK, *MV; bf16_t* OM; };
__device__ __forceinline__ void ma_wg_unit(const MaArgs& A, lptr lds, size_t row0, int bb, int mh, int nblk, int nrows, int tid) {
    asm volatile("" : "+v"(tid));
    const int lane = tid & 63, wave = __builtin_amdgcn_readfirstlane(tid >> 6), r32 = lane & 31, hi = lane >> 5;
    { const bf16_t* Kb = A.MK + (size_t)bb * 65536 + mh * 64; const bf16_t* Vb = A.MV + (size_t)bb * 65536 + mh * 64; u32x4 kv[4], vv[4];
#pragma unroll
      for (int i = 0; i < 4; ++i) { const int idx = tid + 512 * i, row = idx >> 3; kv[i] = *(const u32x4*)(Kb + (size_t)row * 256 + (idx & 7) * 8); vv[i] = *(const u32x4*)(Vb + (size_t)row * 256 + (idx & 7) * 8); }
#pragma unroll
      for (int i = 0; i < 4; ++i) { const int idx = tid + 512 * i, row = idx >> 3, c = idx & 7, rr = row & 63;
          *(MX_LAS u32x4*)(lds + (row >> 6) * WAVE_LDS + KIMG + c * 1024 + ((rr & 56) | ((rr ^ c) & 7)) * 16) = kv[i];
          *(MX_LAS u32x4*)(lds + (row >> 6) * WAVE_LDS + VIMG + (c >> 2) * 4096 + rr * 64 + (c & 3) * 16) = vv[i]; } }
    __syncthreads();
    for (int blk = wave; blk < nblk; blk += 8) {
        const size_t rowq = row0 + 32 * blk; const int qi = nrows >= 32 ? r32 : (r32 & 15);
        bf16x8 qr[4]; { const bf16_t* qp = A.QM + (rowq + qi) * 256 + mh * 64 + hi * 8;
#pragma unroll
            for (int d0 = 0; d0 < 4; ++d0) qr[d0] = *(const bf16x8*)(qp + d0 * 16); }
        float m = -INFINITY;
        for (int T = 0; T < 4; ++T) { f32x16 p0, p1; qkt<true>(p0, p1, lds + T * WAVE_LDS, qr, r32, hi);
#pragma unroll
            for (int r = 0; r < 16; ++r) m = __builtin_fmaxf(m, __builtin_fmaxf(p0[r], p1[r])); }
        { auto rr = __builtin_amdgcn_permlane32_swap(__float_as_uint(m), __float_as_uint(m), false, false); m = __builtin_fmaxf(__uint_as_float(rr[0]), __uint_as_float(rr[1])); }
        float l = 0.f; f32x16 o[2];
#pragma unroll
        for (int r = 0; r < 16; ++r) { o[0][r] = 0.f; o[1][r] = 0.f; }
        for (int T = 0; T < 4; ++T) { f32x16 p0, p1; qkt<true>(p0, p1, lds + T * WAVE_LDS, qr, r32, hi);
#pragma unroll
            for (int r = 0; r < 16; ++r) { p0[r] = __builtin_amdgcn_exp2f(p0[r] - m); p1[r] = __builtin_amdgcn_exp2f(p1[r] - m); l += p0[r] + p1[r]; }
            pv(o, lds + T * WAVE_LDS, p0, p1, lane, hi); }
        { auto rr = __builtin_amdgcn_permlane32_swap(__float_as_uint(l), __float_as_uint(l), false, false); l = __uint_as_float(rr[0]) + __uint_as_float(rr[1]); }
        { MX_LAS float* sc = (MX_LAS float*)(lds + 4 * WAVE_LDS) + wave * 32; if (hi == 0) sc[r32] = 1.0f / l;
#pragma unroll
          for (int r = 0; r < 16; ++r) { const float f = sc[crow(r, hi)]; o[0][r] *= f; o[1][r] *= f; } }
        store_o_staged(o, lds + 4 * WAVE_LDS + 1024 + wave * 4096, A.OM, rowq, 768 + mh * 64, lane, nrows);
    }
    __syncthreads();
}
struct SgArgs { const bf16_t *U, *GV, *WSP; const float *ssv, *g_sgu, *b_sp; bf16_t* OM; float* vout; int gsh_p, ch0, gsh_s, s0; };
constexpr int SG_W = 0, SG_V = 32768, SG_U = 49152, SG_O = 65536, SG_LDS = 81920;
typedef unsigned sg_u32x2 __attribute__((ext_vector_type(2)));
struct SgPre { u32x4 raw[2], uraw[2]; f32x4 sv[2][3]; f32x4 gd[4]; float bias; };
__device__ __forceinline__ void sg_decode(const SgArgs& A, int u, bool sample, int& g, size_t& row0) { const int sh = sample ? A.gsh_s : A.gsh_p, c = u & ((1 << sh) - 1); g = u >> sh; row0 = sample ? (size_t)pg8::MP + 16 * (A.s0 + c) : (size_t)(A.ch0 + c) * 128; }
__device__ __forceinline__ void sg_prefetch(SgPre& P, const SgArgs& A, int u, bool sample, int tid) {
    int g; size_t row0; sg_decode(A, u, sample, g, row0); const int nrows = sample ? 16 : 128;
#pragma unroll
    for (int i = 0; i < 2; ++i) { const int idx = tid + 512 * i, s = idx >> 3, c = idx & 7; const size_t row = row0 + (s < nrows ? s : 0);
        P.raw[i] = *(const u32x4*)(A.GV + row * 768 + g * 64 + c * 8); P.uraw[i] = *(const u32x4*)(A.U + row * 768 + g * 64 + c * 8); const f32x4* sp = (const f32x4*)(A.ssv + row * 12);
#pragma unroll
        for (int j = 0; j < 3; ++j) P.sv[i][j] = sp[j]; }
    { const int lane = tid & 63, wave = tid >> 6, t = 32 * (wave >> 1) + (lane & 31); const bool tok = t < nrows; const size_t row = row0 + (tok ? t : 0);
      const float* gp = A.g_sgu + g * 64 + 32 * (wave & 1) + 4 * (lane >> 5);
#pragma unroll
      for (int i = 0; i < 4; ++i) P.gd[i] = *(const f32x4*)(gp + 8 * i);
      P.bias = A.b_sp[g * 128 + (tok ? t : 0)]; }
}
__device__ __forceinline__ void sg_restage_w(const SgArgs& A, lptr lds, int g, int tid, int npieces) {
    const bf16_t* wg = A.WSP + (size_t)g * 16384; u32x4 w[4];
#pragma unroll
    for (int i = 0; i < 4; ++i) w[i] = *(const u32x4*)(wg + (tid + 512 * (i < npieces ? i : 0)) * 8);
#pragma unroll
    for (int i = 0; i < 4; ++i) if (i < npieces) { const int idx = tid + 512 * i, t = idx >> 4, c = idx & 15; *(MX_LAS u32x4*)(lds + SG_W + t * 256 + ((c ^ (t & 15)) * 16)) = w[i]; }
}
struct SgState { int gcur; int have_prev; size_t prow0; int pg; int pnrows; };
__device__ __forceinline__ void sg_store_out(const SgState& S, const SgArgs& A, lptr lds, int tid) {
#pragma unroll
    for (int i = 0; i < 2; ++i) { const int idx = tid + 512 * i, s = idx >> 3, c = idx & 7;
        if (s < S.pnrows) *(u32x4*)(A.OM + (S.prow0 + s) * 1024 + S.pg * 64 + c * 8) = *(const MX_LAS u32x4*)(lds + SG_O + s * 128 + ((c ^ ((s >> 1) & 7)) * 16)); }
}
template <bool CHECK_G> __device__ __forceinline__ void sg_unit_body(SgPre& P, SgState& S, const SgArgs& A, lptr lds, int u, int u1, bool sample, int tid, int lane, int wave) {
    const int r32 = lane & 31, hi = lane >> 5, tb = wave >> 1, dh = wave & 1, nrows = sample ? 16 : 128;
    int g; size_t row0; sg_decode(A, u, sample, g, row0);
    __syncthreads();
    if (S.have_prev) sg_store_out(S, A, lds, tid);
    if (CHECK_G && g != S.gcur) { S.gcur = g;
        sg_restage_w(A, lds, g, tid, sample ? 1 : 4); }
#pragma unroll
    for (int i = 0; i < 2; ++i) { const int idx = tid + 512 * i, s = idx >> 3, c = idx & 7; const u32x4 raw = P.raw[i];
        float ssum = 0.f;
#pragma unroll
        for (int j = 0; j < 3; ++j) { const f32x4 v = P.sv[i][j]; ssum += (v[0] + v[1]) + (v[2] + v[3]); }
        const float rs = s < nrows ? __builtin_amdgcn_rsqf(ssum * (1.0f / 768.0f) + pg8::RMS_EPS) : 0.f;
        f32x4 a, b2; a[0] = __uint_as_float(raw.x << 16); a[1] = __uint_as_float(raw.x & 0xffff0000u); a[2] = __uint_as_float(raw.y << 16); a[3] = __uint_as_float(raw.y & 0xffff0000u);
        b2[0] = __uint_as_float(raw.z << 16); b2[1] = __uint_as_float(raw.z & 0xffff0000u); b2[2] = __uint_as_float(raw.w << 16); b2[3] = __uint_as_float(raw.w & 0xffff0000u);
        a = a * rs; b2 = b2 * rs;
        *(MX_LAS u32x4*)(lds + SG_V + (c >> 2) * 8192 + s * 64 + (c & 3) * 16) = pk8(a, b2);
        *(MX_LAS u32x4*)(lds + SG_U + s * 128 + ((c ^ ((s >> 1) & 7)) * 16)) = P.uraw[i];
        if (sample && s < nrows) { const float* gp = A.g_sgu + g * 64 + c * 8; const f32x4 ga = *(const f32x4*)gp, gb = *(const f32x4*)(gp + 4);
            float* vo = A.vout + ((row0 - pg8::MP) + s) * 768 + g * 64 + c * 8; *(f32x4*)vo = a * ga; *(f32x4*)(vo + 4) = b2 * gb; } }
    __syncthreads();
    const f32x4 (&gd)[4] = P.gd; const float bias = P.bias;
    if (32 * tb < nrows) {
        const int t = 32 * tb + r32;
        f32x16 acc;
#pragma unroll
        for (int r = 0; r < 16; ++r) acc[r] = 0.f;
        lcptr wp = lds + SG_W + t * 256; lcptr vp = lds + SG_V + dh * 8192 + ((lane >> 4) & 1) * 32 + (lane & 3) * 8 + (8 * hi + ((lane & 15) >> 2)) * 64;
        const int nks = sample ? 1 : 2 * tb + 2;
        for (int ks = 0; ks < nks; ++ks) { const bf16x8 wa = *(const MX_LAS bf16x8*)(wp + (((2 * ks + hi) ^ (t & 15)) * 16));
            const s16x4 lo = vtr(vp + ks * 1024), hh = vtr(vp + ks * 1024 + 256);
            const bf16x8 vf = (bf16x8){lo[0], lo[1], lo[2], lo[3], hh[0], hh[1], hh[2], hh[3]};
            acc = MX_MFMA(vf, wa, acc); }
        {
#pragma unroll
            for (int i = 0; i < 4; ++i) { const int off = t * 128 + (((4 * dh + i) ^ ((t >> 1) & 7)) * 16) + 8 * hi; const sg_u32x2 uu = *(const MX_LAS sg_u32x2*)(lds + SG_U + off);
                const float u0f = __uint_as_float(uu.x << 16), u1f = __uint_as_float(uu.x & 0xffff0000u), u2f = __uint_as_float(uu.y << 16), u3f = __uint_as_float(uu.y & 0xffff0000u);
                sg_u32x2 w; w.x = cvtpk(u0f * (gd[i][0] * acc[4 * i] + bias), u1f * (gd[i][1] * acc[4 * i + 1] + bias)); w.y = cvtpk(u2f * (gd[i][2] * acc[4 * i + 2] + bias), u3f * (gd[i][3] * acc[4 * i + 3] + bias));
                *(MX_LAS sg_u32x2*)(lds + SG_O + off) = w; } }
    }
    S.have_prev = 1; S.prow0 = row0; S.pg = g; S.pnrows = nrows;
    sg_prefetch(P, A, u + 2 < u1 ? u + 2 : u1 - 1, sample, tid);
}
__device__ __forceinline__ void sg_wg_units(const SgArgs& A, lptr lds, int u0, int u1, bool sample, int tid) {
    asm volatile("" : "+v"(tid));
    const int lane = tid & 63, wave = __builtin_amdgcn_readfirstlane(tid >> 6);
    if (u0 >= u1) return;
    SgState S; S.gcur = -1; S.have_prev = 0; S.prow0 = 0; S.pg = 0; S.pnrows = 0;
    const int gshift = sample ? A.gsh_s : A.gsh_p;
    bool even = ((u1 - u0) & 1) == 0;
    for (int g = u0 >> gshift; even && (g << gshift) < u1; ++g) { const int a = (g << gshift) > u0 ? (g << gshift) : u0, b = ((g + 1) << gshift) < u1 ? ((g + 1) << gshift) : u1; if ((b - a) & 1) even = false; }
    if (even) {
        SgPre PA, PB; sg_prefetch(PA, A, u0, sample, tid); sg_prefetch(PB, A, u0 + 1, sample, tid);
        int u = u0;
        while (u < u1) {
            const int g = u >> gshift; int se = (g + 1) << gshift; if (se > u1) se = u1;
            __syncthreads();
            sg_restage_w(A, lds, g, tid, 4);
            for (; u < se; u += 2) { sg_unit_body<false>(PA, S, A, lds, u, u1, sample, tid, lane, wave); sg_unit_body<false>(PB, S, A, lds, u + 1, u1, sample, tid, lane, wave); }
        }
    } else {
        SgPre P;
        for (int u = u0; u < u1; ++u) { sg_prefetch(P, A, u, sample, tid); sg_unit_body<true>(P, S, A, lds, u, u1, sample, tid, lane, wave); }
    }
    __syncthreads();
    if (S.have_prev) sg_store_out(S, A, lds, tid);
    __syncthreads();
}
#undef MX_MFMA
}
namespace sk {
using mx::bf16_t; using mx::bf16x8; using mx::f32x16; using mx::f32x4; using mx::u32x4; using mx::cvtpk;
typedef unsigned u32x2 __attribute__((ext_vector_type(2)));
constexpr int MP = 32768;
__device__ __forceinline__ float rstd16(const float* ss, int row) { return pg8::row_rstd<16>(ss, row, 1.0f / 1024.0f); }
#define SK_GROUP(a, i) (f32x4){a[4 * (i)], a[4 * (i) + 1], a[4 * (i) + 2], a[4 * (i) + 3]}
__device__ __forceinline__ void sk_pin(float& x) { asm volatile("" : "+v"(x)); }
__device__ __forceinline__ void sk_pin(f32x4& x) { asm volatile("" : "+v"(x)); }
__device__ __forceinline__ u32x2 pk4(const f32x4 v) { u32x2 w; w.x = cvtpk(v[0], v[1]); w.y = cvtpk(v[2], v[3]); return w; }
struct SkInA {
    const float* ss; bf16_t *Q, *QM; size_t qkv_stride; float *kout_s, *vout_s;
    __device__ __forceinline__ void wrows(int cu, int& r0, int& r1) const { r0 = 64 * cu; r1 = 64 * cu + 32; }
    typedef float Pre;
    static __device__ __forceinline__ void pin(Pre& p) { sk_pin(p); }
    __device__ __forceinline__ Pre pre(int tb, int cu, int r32, int hi) const { return rstd16(ss, MP + tb * 32 + r32); }
    __device__ __forceinline__ void operator()(const f32x16& a0, const f32x16& a1, int tb, int cu, int r32, int hi, const Pre& rs) const {
        const int n0 = 64 * cu, t = n0 / 768, colw = n0 - 768 * t + 4 * hi; const int tok = tb * 32 + r32, row = MP + tok;
        bf16_t* dst = (t == 3 ? QM + (size_t)row * 256 : Q + (size_t)t * qkv_stride + (size_t)row * 768) + colw;
        float* fo = (t == 1 ? kout_s : vout_s) + (size_t)tok * 768 + colw; const bool wf = (t == 1 || t == 2);
#pragma unroll
        for (int i = 0; i < 4; ++i) { const f32x4 v0 = SK_GROUP(a0, i) * rs, v1 = SK_GROUP(a1, i) * rs;
            *(u32x2*)(dst + 8 * i) = pk4(v0); *(u32x2*)(dst + 32 + 8 * i) = pk4(v1);
            if (wf) { *(f32x4*)(fo + 8 * i) = v0; *(f32x4*)(fo + 32 + 8 * i) = v1; } }
    }
};
template <bool BASE_F32, bool OUT_F32> struct SkResidT {
    const void* base_s; void* out_s; float* ss;
    __device__ __forceinline__ void wrows(int cu, int& r0, int& r1) const { r0 = 64 * cu; r1 = 64 * cu + 32; }
    struct Pre { f32x4 b0[4], b1[4]; };
    static __device__ __forceinline__ void pin(Pre& p) {
#pragma unroll
        for (int i = 0; i < 4; ++i) { sk_pin(p.b0[i]); sk_pin(p.b1[i]); } }
    __device__ __forceinline__ Pre pre(int tb, int cu, int r32, int hi) const { Pre p; const size_t off = (size_t)(tb * 32 + r32) * 1024 + 64 * cu + 4 * hi;
#pragma unroll
        for (int i = 0; i < 4; ++i) {
            if (BASE_F32) { p.b0[i] = *(const f32x4*)((const float*)base_s + off + 8 * i); p.b1[i] = *(const f32x4*)((const float*)base_s + off + 32 + 8 * i); }
            else { const u32x2 r0 = *(const u32x2*)((const bf16_t*)base_s + off + 8 * i), r1 = *(const u32x2*)((const bf16_t*)base_s + off + 32 + 8 * i);
                p.b0[i] = (f32x4){__uint_as_float(r0.x << 16), __uint_as_float(r0.x & 0xffff0000u), __uint_as_float(r0.y << 16), __uint_as_float(r0.y & 0xffff0000u)};
                p.b1[i] = (f32x4){__uint_as_float(r1.x << 16), __uint_as_float(r1.x & 0xffff0000u), __uint_as_float(r1.y << 16), __uint_as_float(r1.y & 0xffff0000u)}; } }
        return p; }
    __device__ __forceinline__ void operator()(const f32x16& a0, const f32x16& a1, int tb, int cu, int r32, int hi, const Pre& P) const {
        const int tok = tb * 32 + r32; const size_t off = (size_t)tok * 1024 + 64 * cu + 4 * hi; float s = 0.f;
#pragma unroll
        for (int i = 0; i < 4; ++i) { const f32x4 v0 = SK_GROUP(a0, i) + P.b0[i], v1 = SK_GROUP(a1, i) + P.b1[i];
            if (OUT_F32) { *(f32x4*)((float*)out_s + off + 8 * i) = v0; *(f32x4*)((float*)out_s + off + 32 + 8 * i) = v1; }
            else { *(u32x2*)((bf16_t*)out_s + off + 8 * i) = pk4(v0); *(u32x2*)((bf16_t*)out_s + off + 32 + 8 * i) = pk4(v1); }
            s += (v0[0] * v0[0] + v0[1] * v0[1]) + (v0[2] * v0[2] + v0[3] * v0[3]) + (v1[0] * v1[0] + v1[1] * v1[1]) + (v1[2] * v1[2] + v1[3] * v1[3]); }
        { auto rr = __builtin_amdgcn_permlane32_swap(__float_as_uint(s), __float_as_uint(s), false, false); s = __uint_as_float(rr[0]) + __uint_as_float(rr[1]); }
        if (hi == 0) ss[(size_t)(MP + tok) * 16 + cu] = s;
    }
};
struct SkGateUp {
    const float* ss; bf16_t* H;
    __device__ __forceinline__ void wrows(int cu, int& r0, int& r1) const { r0 = 256 * (cu >> 2) + 32 * (cu & 3); r1 = r0 + 128; }
    typedef float Pre;
    static __device__ __forceinline__ void pin(Pre& p) { sk_pin(p); }
    __device__ __forceinline__ Pre pre(int tb, int cu, int r32, int hi) const { return rstd16(ss, MP + tb * 32 + r32); }
    __device__ __forceinline__ void operator()(const f32x16& a0, const f32x16& a1, int tb, int cu, int r32, int hi, const Pre& rs) const {
        const int row = MP + tb * 32 + r32; bf16_t* dst = H + (size_t)row * 2816 + 32 * cu + 4 * hi;
#pragma unroll
        for (int i = 0; i < 4; ++i) { const f32x4 g = SK_GROUP(a0, i) * rs, up = SK_GROUP(a1, i) * rs; f32x4 h;
#pragma unroll
            for (int e = 0; e < 4; ++e) h[e] = g[e] * pg8::fast_sigmoid(g[e]) * up[e];
            *(u32x2*)(dst + 8 * i) = pk4(h); }
    }
};
struct SkInB {
    const float* ss; bf16_t *U, *QM; size_t ugv_stride; float* ssv;
    __device__ __forceinline__ void wrows(int cu, int& r0, int& r1) const { r0 = 64 * cu; r1 = 64 * cu + 32; }
    typedef float Pre;
    static __device__ __forceinline__ void pin(Pre& p) { sk_pin(p); }
    __device__ __forceinline__ Pre pre(int tb, int cu, int r32, int hi) const { return rstd16(ss, MP + tb * 32 + r32); }
    __device__ __forceinline__ void operator()(const f32x16& a0, const f32x16& a1, int tb, int cu, int r32, int hi, const Pre& rs) const {
        const int n0 = 64 * cu, t = n0 / 768, colw = n0 - 768 * t + 4 * hi; const int row = MP + tb * 32 + r32;
        bf16_t* dst = (t == 2 ? QM + (size_t)row * 256 : U + (size_t)t * ugv_stride + (size_t)row * 768) + colw; float s = 0.f;
#pragma unroll
        for (int i = 0; i < 4; ++i) { f32x4 v0 = SK_GROUP(a0, i) * rs, v1 = SK_GROUP(a1, i) * rs;
            if (t < 2) {
#pragma unroll
                for (int e = 0; e < 4; ++e) { v0[e] = pg8::gelu_tanh(v0[e]); v1[e] = pg8::gelu_tanh(v1[e]); }
                s += (v0[0] * v0[0] + v0[1] * v0[1]) + (v0[2] * v0[2] + v0[3] * v0[3]) + (v1[0] * v1[0] + v1[1] * v1[1]) + (v1[2] * v1[2] + v1[3] * v1[3]); }
            *(u32x2*)(dst + 8 * i) = pk4(v0); *(u32x2*)(dst + 32 + 8 * i) = pk4(v1); }
        if (t == 1) { auto rr = __builtin_amdgcn_permlane32_swap(__float_as_uint(s), __float_as_uint(s), false, false); s = __uint_as_float(rr[0]) + __uint_as_float(rr[1]);
            if (hi == 0) ssv[(size_t)row * 12 + (n0 - 768) / 64] = s; }
    }
};
struct SkMemKV {
    const float* rsm; bf16_t *MK, *MV; float *ko, *vo; int l;
    __device__ __forceinline__ void wrows(int cu, int& r0, int& r1) const { r0 = l * 512 + 64 * cu; r1 = r0 + 32; }
    typedef float Pre;
    static __device__ __forceinline__ void pin(Pre& p) { sk_pin(p); }
    __device__ __forceinline__ Pre pre(int tb, int cu, int r32, int hi) const { return rsm[tb * 32 + r32]; }
    __device__ __forceinline__ void operator()(const f32x16& a0, const f32x16& a1, int tb, int cu, int r32, int hi, const Pre& rs) const {
        const int row = tb * 32 + r32; const bool isv = cu >= 4; const int colw = 64 * (cu & 3) + 4 * hi;
        bf16_t* dst = (isv ? MV : MK) + (size_t)l * 24 * 65536 + (size_t)row * 256 + colw; float* fo = (isv ? vo : ko) + (size_t)l * 2048 * 256 + (size_t)row * 256 + colw;
#pragma unroll
        for (int i = 0; i < 4; ++i) { const f32x4 v0 = SK_GROUP(a0, i) * rs, v1 = SK_GROUP(a1, i) * rs;
            *(u32x2*)(dst + 8 * i) = pk4(v0); *(u32x2*)(dst + 32 + 8 * i) = pk4(v1); *(f32x4*)(fo + 8 * i) = v0; *(f32x4*)(fo + 32 + 8 * i) = v1; }
    }
};
template <class Epi> __device__ __forceinline__ void skinny_phase(MX_LAS unsigned char* lds, const bf16_t* X, const bf16_t* Wt, int K, int ncu, const Epi& E, int ntb = 8, int wg0 = 0) {
    int tid = threadIdx.x; asm volatile("" : "+v"(tid));
    const int wave = __builtin_amdgcn_readfirstlane(tid >> 6), lane = tid & 63, r32 = lane & 31, hi = lane >> 5;
    MX_LAS float* red = (MX_LAS float*)lds;
    const int kper = K >> 3, nst = kper >> 4;
    if ((int)blockIdx.x < wg0) return;
    for (int u = blockIdx.x - wg0; u < ntb * ncu; u += gridDim.x - wg0) {
        const int tb = u % ntb, cu = u / ntb; int wr0, wr1; E.wrows(cu, wr0, wr1);
        const bf16_t* xp = X + (size_t)(tb * 32 + r32) * K + wave * kper + hi * 8;
        const bf16_t* w0 = Wt + (size_t)(wr0 + r32) * K + wave * kper + hi * 8; const bf16_t* w1 = Wt + (size_t)(wr1 + r32) * K + wave * kper + hi * 8;
        typename Epi::Pre pre = {}; if (wave == 0) pre = E.pre(tb, cu, r32, hi);
        f32x16 a0, a1;
#pragma unroll
        for (int r = 0; r < 16; ++r) { a0[r] = 0.f; a1[r] = 0.f; }
#pragma unroll 8
        for (int s = 0; s < nst; ++s) { const bf16x8 xf = *(const bf16x8*)(xp + 16 * s), f0 = *(const bf16x8*)(w0 + 16 * s), f1 = *(const bf16x8*)(w1 + 16 * s);
            a0 = __builtin_amdgcn_mfma_f32_32x32x16_bf16(f0, xf, a0, 0, 0, 0); a1 = __builtin_amdgcn_mfma_f32_32x32x16_bf16(f1, xf, a1, 0, 0, 0); }
#pragma unroll
        for (int r = 0; r < 16; ++r) { red[(wave * 32 + r) * 64 + lane] = a0[r]; red[(wave * 32 + 16 + r) * 64 + lane] = a1[r]; }
        __syncthreads();
        {
            MX_LAS float* fin = red + 8 * 32 * 64;
#pragma unroll
            for (int j = 0; j < 4; ++j) { const int reg = 4 * wave + j; float s0 = 0.f;
#pragma unroll
                for (int w = 0; w < 8; ++w) s0 += red[(w * 32 + reg) * 64 + lane];
                fin[reg * 64 + lane] = s0; }
        }
        __syncthreads();
        if (wave == 0) {
            MX_LAS const float* fin = red + 8 * 32 * 64;
#pragma unroll
            for (int r = 0; r < 16; ++r) { a0[r] = fin[r * 64 + lane]; a1[r] = fin[(16 + r) * 64 + lane]; }
            E(a0, a1, tb, cu, r32, hi, pre);
        }
        __syncthreads();
    }
}
template <class Epi> __device__ __forceinline__ void skinny_phase_k1024(MX_LAS unsigned char* lds, const bf16_t* X, const bf16_t* Wt, int ncu, const Epi& E, int ntb, int tb0, int first, int stride) {
    int tid = threadIdx.x; asm volatile("" : "+v"(tid));
    const int wave = __builtin_amdgcn_readfirstlane(tid >> 6), lane = tid & 63, r32 = lane & 31, hi = lane >> 5;
    constexpr int K = 1024, TILE = 96 * 128;
    MX_LAS unsigned char* tile = lds + wave * TILE;
    MX_LAS float* fin = (MX_LAS float*)(lds + 8 * TILE);
    const int total = ntb * ncu; int u = first;
    if (u < 0 || u >= total) return;
    u32x4 RA[12], RB[12];
    const int lrow = lane >> 3, lc = lane & 7;
#define SK_LOAD(uu) do { const int tb_ = tb0 + (uu) % ntb, cu_ = (uu) / ntb; int r0_, r1_; E.wrows(cu_, r0_, r1_); \
        const bf16_t* px_ = X + (size_t)(tb_ * 32 + lrow) * K + wave * 128 + lc * 8; const bf16_t* p0_ = Wt + (size_t)(r0_ + lrow) * K + wave * 128 + lc * 8; const bf16_t* p1_ = Wt + (size_t)(r1_ + lrow) * K + wave * 128 + lc * 8; \
        _Pragma("unroll") for (int j_ = 0; j_ < 4; ++j_) { RA[j_] = *(const u32x4*)(px_ + (size_t)j_ * 8 * K); RA[4 + j_] = *(const u32x4*)(p0_ + (size_t)j_ * 8 * K); RA[8 + j_] = *(const u32x4*)(p1_ + (size_t)j_ * 8 * K); \
                                                            RB[j_] = *(const u32x4*)(px_ + (size_t)j_ * 8 * K + 64); RB[4 + j_] = *(const u32x4*)(p0_ + (size_t)j_ * 8 * K + 64); RB[8 + j_] = *(const u32x4*)(p1_ + (size_t)j_ * 8 * K + 64); } } while (0)
#define SK_STAGE(R) do { _Pragma("unroll") for (int j_ = 0; j_ < 12; ++j_) { const int row_ = 8 * j_ + lrow; *(MX_LAS u32x4*)(tile + row_ * 128 + ((lc ^ ((row_ >> 1) & 7)) * 16)) = R[j_]; } } while (0)
#define SK_MMA() do { _Pragma("unroll") for (int s_ = 0; s_ < 4; ++s_) { const int sl_ = ((2 * s_ + hi) ^ ((r32 >> 1) & 7)) * 16; \
        const bf16x8 xf_ = *(const MX_LAS bf16x8*)(tile + r32 * 128 + sl_), f0_ = *(const MX_LAS bf16x8*)(tile + (32 + r32) * 128 + sl_), f1_ = *(const MX_LAS bf16x8*)(tile + (64 + r32) * 128 + sl_); \
        a0 = __builtin_amdgcn_mfma_f32_32x32x16_bf16(f0_, xf_, a0, 0, 0, 0); a1 = __builtin_amdgcn_mfma_f32_32x32x16_bf16(f1_, xf_, a1, 0, 0, 0); } } while (0)
    SK_LOAD(u);
    for (;;) {
        const int tb = tb0 + u % ntb, cu = u / ntb;
        typename Epi::Pre pre = {}; if (wave == 0) pre = E.pre(tb, cu, r32, hi);
        f32x16 a0, a1;
#pragma unroll
        for (int r = 0; r < 16; ++r) { a0[r] = 0.f; a1[r] = 0.f; }
        SK_STAGE(RA); SK_MMA();
        asm volatile("" ::: "memory");
        SK_STAGE(RB); SK_MMA();
        const int un = u + stride; const bool more = un < total;
        Epi::pin(pre);
        if (more) SK_LOAD(un);
        { MX_LAS float* red = (MX_LAS float*)tile;
#pragma unroll
          for (int r = 0; r < 16; ++r) { red[r * 64 + lane] = a0[r]; red[(16 + r) * 64 + lane] = a1[r]; } }
        __syncthreads();
        {
#pragma unroll
            for (int j = 0; j < 4; ++j) { const int reg = 4 * wave + j; float s0 = 0.f;
#pragma unroll
                for (int w = 0; w < 8; ++w) s0 += ((const MX_LAS float*)(lds + w * TILE))[reg * 64 + lane];
                fin[reg * 64 + lane] = s0; }
        }
        __syncthreads();
        if (wave == 0) {
#pragma unroll
            for (int r = 0; r < 16; ++r) { a0[r] = fin[r * 64 + lane]; a1[r] = fin[(16 + r) * 64 + lane]; }
            E(a0, a1, tb, cu, r32, hi, pre);
        }
        __syncthreads();
        if (!more) break;
        u = un;
    }
#undef SK_LOAD
#undef SK_STAGE
#undef SK_MMA
}
template <class Epi> __device__ __forceinline__ void skinny_phase_k2816(MX_LAS unsigned char* lds, const bf16_t* X, const bf16_t* Wt, int ncu, const Epi& E, int ntb, int tb0, int first, int stride) {
    int tid = threadIdx.x; asm volatile("" : "+v"(tid));
    const int wave = __builtin_amdgcn_readfirstlane(tid >> 6), lane = tid & 63, r32 = lane & 31, hi = lane >> 5;
    constexpr int K = 2816, TILE = 96 * 128;
    MX_LAS unsigned char* tile = lds + wave * TILE;
    MX_LAS float* fin = (MX_LAS float*)(lds + 8 * TILE);
    const int nch = wave < 4 ? 6 : 5, c0 = wave < 4 ? 6 * wave : 24 + 5 * (wave - 4);
    const int lrow = lane >> 3, lc = lane & 7;
    if (first < 0) return;
    for (int u = first; u < ntb * ncu; u += stride) {
        const int tb = tb0 + u % ntb, cu = u / ntb; int wr0, wr1; E.wrows(cu, wr0, wr1);
        const bf16_t* px = X + (size_t)(tb * 32 + lrow) * K + lc * 8; const bf16_t* p0 = Wt + (size_t)(wr0 + lrow) * K + lc * 8; const bf16_t* p1 = Wt + (size_t)(wr1 + lrow) * K + lc * 8;
        u32x4 RA[12], RB[12];
#define SK_LOADC(R, ci) do { const int co_ = 64 * (c0 + ((ci) < nch ? (ci) : nch - 1)); \
        _Pragma("unroll") for (int j_ = 0; j_ < 4; ++j_) { R[j_] = *(const u32x4*)(px + (size_t)j_ * 8 * K + co_); R[4 + j_] = *(const u32x4*)(p0 + (size_t)j_ * 8 * K + co_); R[8 + j_] = *(const u32x4*)(p1 + (size_t)j_ * 8 * K + co_); } } while (0)
#define SK_STAGE(R) do { _Pragma("unroll") for (int j_ = 0; j_ < 12; ++j_) { const int row_ = 8 * j_ + lrow; *(MX_LAS u32x4*)(tile + row_ * 128 + ((lc ^ ((row_ >> 1) & 7)) * 16)) = R[j_]; } } while (0)
#define SK_MMA() do { _Pragma("unroll") for (int s_ = 0; s_ < 4; ++s_) { const int sl_ = ((2 * s_ + hi) ^ ((r32 >> 1) & 7)) * 16; \
        const bf16x8 xf_ = *(const MX_LAS bf16x8*)(tile + r32 * 128 + sl_), f0_ = *(const MX_LAS bf16x8*)(tile + (32 + r32) * 128 + sl_), f1_ = *(const MX_LAS bf16x8*)(tile + (64 + r32) * 128 + sl_); \
        a0 = __builtin_amdgcn_mfma_f32_32x32x16_bf16(f0_, xf_, a0, 0, 0, 0); a1 = __builtin_amdgcn_mfma_f32_32x32x16_bf16(f1_, xf_, a1, 0, 0, 0); } } while (0)
        SK_LOADC(RA, 0); SK_LOADC(RB, 1);
        typename Epi::Pre pre = {}; if (wave == 0) pre = E.pre(tb, cu, r32, hi);
        f32x16 a0, a1;
#pragma unroll
        for (int r = 0; r < 16; ++r) { a0[r] = 0.f; a1[r] = 0.f; }
#pragma unroll
        for (int i = 0; i < 6; i += 2) {
            SK_STAGE(RA); SK_MMA(); asm volatile("" ::: "memory");
            if (i + 2 < 6) SK_LOADC(RA, i + 2);
            if (i + 1 < nch) { SK_STAGE(RB); SK_MMA(); } asm volatile("" ::: "memory");
            if (i + 3 < 6) SK_LOADC(RB, i + 3);
        }
        { MX_LAS float* red = (MX_LAS float*)tile;
#pragma unroll
          for (int r = 0; r < 16; ++r) { red[r * 64 + lane] = a0[r]; red[(16 + r) * 64 + lane] = a1[r]; } }
        __syncthreads();
        {
#pragma unroll
            for (int j = 0; j < 4; ++j) { const int reg = 4 * wave + j; float s0 = 0.f;
#pragma unroll
                for (int w = 0; w < 8; ++w) s0 += ((const MX_LAS float*)(lds + w * TILE))[reg * 64 + lane];
                fin[reg * 64 + lane] = s0; }
        }
        __syncthreads();
        if (wave == 0) {
#pragma unroll
            for (int r = 0; r < 16; ++r) { a0[r] = fin[r * 64 + lane]; a1[r] = fin[(16 + r) * 64 + lane]; }
            E(a0, a1, tb, cu, r32, hi, pre);
        }
        __syncthreads();
#undef SK_LOADC
#undef SK_STAGE
#undef SK_MMA
    }
}
#undef SK_GROUP
}
constexpr int NWAVES = 8;
constexpr int D = 1024, MP = 32768, MS = 256, MTOT = MP + MS, DFF = 2816, NMEMROWS = 2048;
constexpr float QSCALE = 0.125f * 1.4426950408889634f;
constexpr float EPS = 1e-6f;
constexpr size_t O_YP = 0, O_YS = 33554432, O_KP = 33816576, O_VP = 58982400, O_KS = 84148224, O_VS = 84344832, O_MK = 84541440, O_MV = 85590016, O_SV = 86638592, O_END = 86835200;
constexpr size_t MiB = 1u << 20;
constexpr size_t WS_CTL = 0, CTL_ZERO_BYTES = 65536;
constexpr size_t WS_WINA = 1 * MiB;
constexpr size_t WS_WINB = 6 * MiB;
constexpr size_t WS_WMKV = 10 * MiB;
constexpr size_t WS_WOUT = 12 * MiB;
constexpr size_t WS_WGU = 16 * MiB;
constexpr size_t WS_WDN = 38 * MiB;
constexpr size_t WS_WSP = 49 * MiB;
constexpr size_t WS_RSM = 50 * MiB;
constexpr size_t WS_SS = 51 * MiB;
constexpr size_t WS_SSV = 54 * MiB;
constexpr size_t WS_MB = 56 * MiB;
constexpr size_t WS_MK = 60 * MiB;
constexpr size_t WS_MV = 66 * MiB;
constexpr size_t WS_XB = 72 * MiB;
constexpr size_t WS_Q = 137 * MiB;
constexpr size_t WS_K = 186 * MiB;
constexpr size_t WS_V = 235 * MiB;
constexpr size_t WS_QM = 284 * MiB;
constexpr size_t WS_OM = 301 * MiB;
constexpr size_t WS_H = 366 * MiB;
constexpr size_t WS_END = 544 * MiB;
static_assert(WS_WINA + 2560ull * 1024 * 2 <= WS_WINB && WS_WINB + 1792ull * 1024 * 2 <= WS_WMKV && WS_WMKV + 1024ull * 1024 * 2 <= WS_WOUT && WS_WOUT + 2ull * 1024 * 1024 * 2 <= WS_WGU &&
              WS_WGU + 2ull * 5632 * 1024 * 2 <= WS_WDN && WS_WDN + 2ull * 1024 * 2816 * 2 <= WS_WSP && WS_WSP + 12ull * 128 * 128 * 2 <= WS_RSM && WS_SS + (size_t)MTOT * 64 <= WS_SSV &&
              WS_SSV + (size_t)MTOT * 48 <= WS_MB && WS_MB + 2048ull * 1024 * 2 <= WS_MK && WS_MK + 2ull * 24 * 65536 * 2 <= WS_MV && WS_MV + 2ull * 24 * 65536 * 2 <= WS_XB &&
              WS_XB + (size_t)MTOT * 1024 * 2 <= WS_Q && WS_Q + (size_t)MTOT * 768 * 2 <= WS_K && WS_K + (size_t)MTOT * 768 * 2 <= WS_V && WS_V + (size_t)MTOT * 768 * 2 <= WS_QM &&
              WS_V - WS_K == WS_K - WS_Q && WS_QM + (size_t)MTOT * 256 * 2 <= WS_OM && WS_OM + (size_t)MTOT * 1024 * 2 <= WS_H && WS_H + (size_t)MTOT * 2816 * 2 <= WS_END, "d_ws map");
constexpr int CW_FQ = 8192;
constexpr int CW_BAR = 4096;
static_assert((CW_BAR + 3456) <= CW_FQ && (CW_FQ + 512) * 4 <= (int)CTL_ZERO_BYTES, "barrier words and queue words inside the memset region");
constexpr int RING_OFF = 0, RING_BYTES = 131072;
constexpr int LDSCTL_OFF = RING_BYTES, MISC_OFF = LDSCTL_OFF + 320;
constexpr int RC_OFF = RING_BYTES + 1024, RC_STRIDE = 528;
constexpr int LDS_BYTES = 147456;
static_assert(MISC_OFF + 128 <= RC_OFF && RC_OFF + 8 * RC_STRIDE <= LDS_BYTES, "LDS map");

#define GAS __attribute__((address_space(1)))
#define LAS __attribute__((address_space(3)))
typedef unsigned short bf16;
typedef unsigned v4u __attribute__((ext_vector_type(4)));
typedef float f32x4 __attribute__((ext_vector_type(4)));
#define RLX_AGENT __ATOMIC_RELAXED, __HIP_MEMORY_SCOPE_AGENT
#define LDS_WAIT() asm volatile("s_waitcnt lgkmcnt(0)" ::: "memory")
__device__ __forceinline__ unsigned pk2(float lo, float hi) { return mx::cvtpk(lo, hi); }
__device__ __forceinline__ float wave_sum(float v) {
#pragma unroll
    for (int o = 1; o < 64; o <<= 1) v += __shfl_xor(v, o);
    return v;
}

#define XB_TMO      128
#define XB_XCNT(j)  (256  + 64 * (j))
#define XB_XSUB(j)  (1280 + 64 * (j))
#define XB_XGEN(j)  (2304 + 64 * (j))
#define XB_TOP      3328
#define XB_TOPGEN   3392
#define XCD_BAR_WORDS 3456
#define XB_SPIN_CAP (1u << 18)

__device__ __forceinline__ unsigned xb_ld(unsigned* p)              { return __hip_atomic_load(p, __ATOMIC_RELAXED, __HIP_MEMORY_SCOPE_AGENT); }
__device__ __forceinline__ unsigned xb_add(unsigned* p, unsigned v) { return __hip_atomic_fetch_add(p, v, __ATOMIC_RELAXED, __HIP_MEMORY_SCOPE_AGENT); }
__device__ __forceinline__ unsigned xb_xcc_id() { return (unsigned)__builtin_amdgcn_s_getreg((3 << 11) | 20) & 0xFu; }
#define XB_SPIN(cond, bar) do { unsigned _sp = 0; while (cond) { __builtin_amdgcn_s_sleep(1); \
    if ((++_sp & 255u) == 0u) { if (xb_ld(&(bar)[XB_TMO])) break; if (_sp > XB_SPIN_CAP) { atomicAdd(&(bar)[XB_TMO], 1u); break; } } } } while (0)

struct XcdBarrier {
    unsigned* bar; unsigned x;
    volatile LAS unsigned* st;
};

__device__ __forceinline__ XcdBarrier xcd_barrier_post(unsigned* bar, volatile LAS unsigned* st) {
    XcdBarrier b; b.bar = bar; b.x = xb_xcc_id(); b.st = st;
    if (threadIdx.x == 0) st[2] = xb_add(&bar[XB_XCNT(b.x)], 1u);
    return b;
}
__device__ __forceinline__ void xcd_barrier_complete(unsigned* bar, unsigned x, unsigned& nloc, unsigned& nx) {
    const unsigned G = gridDim.x * gridDim.y * gridDim.z;
    unsigned sum, cnt, mine, sp = 0u;
    for (;;) {
        sum = 0u; cnt = 0u; mine = 0u;
#pragma unroll
        for (unsigned j = 0; j < 16; ++j) { const unsigned c = xb_ld(&bar[XB_XCNT(j)]); sum += c; cnt += (c > 0u) ? 1u : 0u; mine = (j == x) ? c : mine; }
        if (sum == G) break;
        __builtin_amdgcn_s_sleep(1);
        if ((++sp & 255u) == 0u) { if (xb_ld(&bar[XB_TMO])) break; if (sp > XB_SPIN_CAP) { atomicAdd(&bar[XB_TMO], 1u); break; } }
    }
    nloc = mine > 0u ? mine : 1u; nx = cnt > 0u ? cnt : 1u;
}

__device__ __forceinline__ void xcd_barrier(const XcdBarrier& b) {
    asm volatile("s_waitcnt vmcnt(0)" ::: "memory");
    __syncthreads();
    if (threadIdx.x == 0) {
        unsigned* bar = b.bar; asm volatile("" : "+s"(bar)); unsigned bx = b.x; asm volatile("" : "+s"(bx));
        __builtin_amdgcn_s_waitcnt(0);
        unsigned nloc = b.st[0], nx = b.st[1];
        if (nloc == 0u) { xcd_barrier_complete(bar, bx, nloc, nx); b.st[0] = nloc; b.st[1] = nx; }
        const unsigned old = xb_add(&bar[XB_XSUB(bx)], 1u);
        const unsigned gen = old / nloc;
        if (old + 1u == (gen + 1u) * nloc) {
            __builtin_amdgcn_fence(__ATOMIC_RELEASE, "agent");
            asm volatile("s_waitcnt vmcnt(0)" ::: "memory");
            const unsigned og = xb_add(&bar[XB_TOP], 1u);
            const unsigned tg = og / nx;
            if (og + 1u == (tg + 1u) * nx) xb_add(&bar[XB_TOPGEN], 1u);
            else XB_SPIN(xb_ld(&bar[XB_TOPGEN]) == tg, bar);
            __builtin_amdgcn_fence(__ATOMIC_ACQUIRE, "agent");
            xb_add(&bar[XB_XGEN(bx)], 1u);
            asm volatile("s_waitcnt vmcnt(0)" ::: "memory");
        } else {
            XB_SPIN(xb_ld(&bar[XB_XGEN(bx)]) == gen, bar);
            __builtin_amdgcn_fence(__ATOMIC_ACQUIRE, "agent");
            asm volatile("s_waitcnt vmcnt(0)" ::: "memory");
        }
    }
    __syncthreads();
}

constexpr bool MK_FORCE_GLOBAL_GROUPS = false;
__device__ __forceinline__ void xcd_group_setup(const XcdBarrier& b) {
    if (threadIdx.x == 0) {
        unsigned* bar = b.bar; const unsigned G = gridDim.x, x = b.x; unsigned cnt = 0u, ord = 0u, ok = (G % 8u == 0u) ? 1u : 0u;
#pragma unroll
        for (unsigned j = 0; j < 16; ++j) { const unsigned c = xb_ld(&bar[XB_XCNT(j)]); if (c) { ++cnt; ord += (j < x) ? 1u : 0u; if (c * 8u != G) ok = 0u; } }
        const bool local = !MK_FORCE_GLOBAL_GROUPS && ok && cnt == 8u;
        b.st[3] = local ? 1u : 0u;
        if (local) { b.st[4] = ord; b.st[5] = b.st[2]; b.st[6] = G / 8u; b.st[7] = 1u; }
        else if (G % 8u == 0u) { b.st[4] = blockIdx.x % 8u; b.st[5] = blockIdx.x / 8u; b.st[6] = G / 8u; b.st[7] = 1u; }
        else { b.st[4] = 0u; b.st[5] = blockIdx.x; b.st[6] = G; b.st[7] = 8u; }
    }
    __syncthreads();
}
__device__ __forceinline__ void grp_barrier(const XcdBarrier& b) {
    if (b.st[3] == 0u) { xcd_barrier(b); return; }
    asm volatile("s_waitcnt vmcnt(0)" ::: "memory");
    __syncthreads();
    if (threadIdx.x == 0) {
        unsigned* bar = b.bar; asm volatile("" : "+s"(bar)); unsigned bx = b.x; asm volatile("" : "+s"(bx));
        __builtin_amdgcn_s_waitcnt(0);
        const unsigned nloc = b.st[0];
        const unsigned old = xb_add(&bar[XB_XSUB(bx)], 1u);
        const unsigned gen = old / nloc;
        if (old + 1u == (gen + 1u) * nloc) xb_add(&bar[XB_XGEN(bx)], 1u);
        else XB_SPIN(xb_ld(&bar[XB_XGEN(bx)]) == gen, bar);
        __builtin_amdgcn_fence(__ATOMIC_ACQUIRE, "agent");
        asm volatile("s_waitcnt vmcnt(0)" ::: "memory");
    }
    __syncthreads();
}


struct Params {
    const float *xp, *xs, *csk, *csv, *cmk, *cmv, *memp, *g_mix, *w_in_a, *w_in_b, *w_sp, *b_sp, *g_sgu, *g_mem, *w_mem_kv, *w_out, *g_ffn, *w_gate, *w_up, *w_down, *g_final;
    float* out; unsigned char* ws;
};

template <int MODE> __device__ __forceinline__ void tr_item(const float* W, int K, int N, bf16* WT, const float* g, LAS float* scr, int item, int lane) {
    const int nblk = N / 32, kb = item / nblk, nb = item % nblk, k0 = 64 * kb, n0 = 32 * nb;
    f32x4 v[8]; float gk[8];
#pragma unroll
    for (int i = 0; i < 8; ++i) { const int kk = (lane >> 3) + 8 * i; v[i] = *(const GAS f32x4*)(W + (size_t)(k0 + kk) * N + n0 + (lane & 7) * 4); gk[i] = g ? g[k0 + kk] : 1.f; }
#pragma unroll
    for (int i = 0; i < 8; ++i) { const int kk = (lane >> 3) + 8 * i; LAS float* d = scr + kk * 33 + (lane & 7) * 4; const f32x4 w = v[i] * gk[i]; d[0] = w[0]; d[1] = w[1]; d[2] = w[2]; d[3] = w[3]; }
    LDS_WAIT(); asm volatile("" ::: "memory");
    float sc = 1.f; int dr = n0;
    if (MODE == 1) sc = (n0 < 768 || n0 >= 2304) ? QSCALE : 1.f;
    if (MODE == 2) sc = (n0 >= 1536) ? QSCALE : 1.f;
    if (MODE == 3) dr = 256 * (n0 >> 7) + (n0 & 127);
    if (MODE == 4) dr = 256 * (n0 >> 7) + 128 + (n0 & 127);
    const int c = lane & 7;
#pragma unroll
    for (int j = 0; j < 4; ++j) { const int n = (lane >> 3) + 8 * j; const LAS float* s = scr + (8 * c) * 33 + n;
        v4u o; o.x = pk2(s[0 * 33] * sc, s[1 * 33] * sc); o.y = pk2(s[2 * 33] * sc, s[3 * 33] * sc); o.z = pk2(s[4 * 33] * sc, s[5 * 33] * sc); o.w = pk2(s[6 * 33] * sc, s[7 * 33] * sc);
        *(GAS v4u*)(WT + (size_t)(dr + n) * K + k0 + 8 * c) = o; }
    LDS_WAIT(); asm volatile("" ::: "memory");
}
__device__ __forceinline__ float row_to_bf16(const float* xrow, bf16* orow, int lane) {
    const GAS f32x4* xr = (const GAS f32x4*)xrow + lane; f32x4 v[4]; float s = 0.f;
#pragma unroll
    for (int j = 0; j < 4; ++j) { v[j] = xr[64 * j]; s += (v[j].x * v[j].x + v[j].y * v[j].y) + (v[j].z * v[j].z + v[j].w * v[j].w); }
    GAS unsigned long long* o8 = (GAS unsigned long long*)orow + lane;
#pragma unroll
    for (int j = 0; j < 4; ++j) o8[64 * j] = (unsigned long long)pk2(v[j].x, v[j].y) | ((unsigned long long)pk2(v[j].z, v[j].w) << 32);
    return wave_sum(s);
}

typedef const Params __attribute__((address_space(4))) CParams;
#define ENV() CParams* q = (CParams*)__builtin_amdgcn_kernarg_segment_ptr(); asm volatile("" : "+s"(q)); unsigned char* const ws = q->ws; (void)ws; \
    int tid_ = threadIdx.x; asm volatile("" : "+v"(tid_)); const int tid = tid_, lane = tid & 63, wave = __builtin_amdgcn_readfirstlane(tid >> 6); const int G = gridDim.x, gw = blockIdx.x * NWAVES + wave, NGW = G * NWAVES; \
    (void)lane; (void)gw; (void)NGW; const int vcu = (G % 8 == 0) ? (int)(blockIdx.x % 8) * (G / 8) + (int)(blockIdx.x / 8) : (int)blockIdx.x; (void)vcu; LAS unsigned char* const lds = (LAS unsigned char*)lds_raw; LAS float* const rcs = (LAS float*)(lds + RC_OFF + wave * RC_STRIDE); (void)rcs; LAS unsigned char* const wslot = lds + RING_OFF + wave * mx::WAVE_LDS; (void)wslot
#define WSB(off) ((bf16*)(ws + (off)))
#define WSF(off) ((float*)(ws + (off)))
__global__ void __launch_bounds__(NWAVES * 64, 2) mk_fwd(Params Pdummy) {
    extern __shared__ __attribute__((aligned(16))) unsigned char lds_raw[];
    XcdBarrier bar;
    { ENV();
      for (int u = tid; u < (LDS_BYTES - LDSCTL_OFF) / 4; u += NWAVES * 64) ((LAS unsigned*)(lds + LDSCTL_OFF))[u] = 0u;
      __syncthreads();
      bar = xcd_barrier_post((unsigned*)(ws + WS_CTL) + CW_BAR, (volatile LAS unsigned*)(lds + MISC_OFF) + 8); }

    { ENV();
        bf16* WINA = WSB(WS_WINA); bf16* WINB = WSB(WS_WINB); bf16* WMKV = WSB(WS_WMKV); bf16* WOUT = WSB(WS_WOUT); bf16* WGU = WSB(WS_WGU); bf16* WDN = WSB(WS_WDN);
        LAS float* scr = (LAS float*)(lds + RING_OFF + wave * 16384);
        constexpr int I_A = 16 * 80, I_B = 16 * 56, I_M = 16 * 16, I_O = 16 * 32, I_G = 16 * 88, I_D = 44 * 32;
        constexpr int NITEMS = I_A + I_B + 2 * I_M + 2 * I_O + 4 * I_G + 2 * I_D;
        for (int it = gw; it < NITEMS; it += NGW) {
            int r = it;
            if (r < I_A) { tr_item<1>(q->w_in_a, 1024, 2560, WINA, q->g_mix, scr, r, lane); continue; } r -= I_A;
            if (r < I_B) { tr_item<2>(q->w_in_b, 1024, 1792, WINB, q->g_mix + 1024, scr, r, lane); continue; } r -= I_B;
            if (r < 2 * I_M) { const int l = r / I_M; tr_item<0>(q->w_mem_kv + (size_t)l * 1024 * 512, 1024, 512, WMKV + (size_t)l * 512 * 1024, q->g_mem + l * 1024, scr, r - l * I_M, lane); continue; } r -= 2 * I_M;
            if (r < 2 * I_O) { const int l = r / I_O; tr_item<0>(q->w_out + (size_t)l * 1024 * 1024, 1024, 1024, WOUT + (size_t)l * 1024 * 1024, nullptr, scr, r - l * I_O, lane); continue; } r -= 2 * I_O;
            if (r < 2 * I_G) { const int l = r / I_G; tr_item<3>(q->w_gate + (size_t)l * 1024 * DFF, 1024, DFF, WGU + (size_t)l * 5632 * 1024, q->g_ffn + l * 1024, scr, r - l * I_G, lane); continue; } r -= 2 * I_G;
            if (r < 2 * I_G) { const int l = r / I_G; tr_item<4>(q->w_up + (size_t)l * 1024 * DFF, 1024, DFF, WGU + (size_t)l * 5632 * 1024, q->g_ffn + l * 1024, scr, r - l * I_G, lane); continue; } r -= 2 * I_G;
            { const int l = r / I_D; tr_item<0>(q->w_down + (size_t)l * DFF * 1024, DFF, 1024, WDN + (size_t)l * 1024 * DFF, nullptr, scr, r - l * I_D, lane); }
        }
        { bf16* XB = WSB(WS_XB); float* SS = WSF(WS_SS); const float* xp = q->xp; const float* xs = q->xs;
          for (int m = 4 * gw; m < MTOT; m += 4 * NGW) {
            const float* x0 = m < MP ? xp + (size_t)m * D : xs + (size_t)(m - MP) * D;
            f32x4 v[4][4]; float s[4];
#pragma unroll
            for (int k = 0; k < 4; ++k) { const GAS f32x4* r = (const GAS f32x4*)(x0 + (size_t)k * D) + lane;
#pragma unroll
                for (int j = 0; j < 4; ++j) v[k][j] = r[64 * j]; }
#pragma unroll
            for (int k = 0; k < 4; ++k) { float t = 0.f;
#pragma unroll
                for (int j = 0; j < 4; ++j) t += (v[k][j].x * v[k][j].x + v[k][j].y * v[k][j].y) + (v[k][j].z * v[k][j].z + v[k][j].w * v[k][j].w);
                GAS unsigned long long* o = (GAS unsigned long long*)(XB + (size_t)(m + k) * D) + lane;
#pragma unroll
                for (int j = 0; j < 4; ++j) o[64 * j] = (unsigned long long)pk2(v[k][j].x, v[k][j].y) | ((unsigned long long)pk2(v[k][j].z, v[k][j].w) << 32);
                s[k] = wave_sum(t); }
            { const int k = lane >> 4; const float sk = k == 0 ? s[0] : k == 1 ? s[1] : k == 2 ? s[2] : s[3]; SS[(size_t)m * 16 + lane] = (lane & 15) == 0 ? sk : 0.f; } } }
        { bf16* MB = WSB(WS_MB); float* RSM = WSF(WS_RSM); const float* memp = q->memp;
          for (int m = gw; m < NMEMROWS; m += NGW) { const float s = row_to_bf16(memp + (size_t)m * D, MB + (size_t)m * D, lane); if (lane == 0) RSM[m] = __builtin_amdgcn_rsqf(s * (1.0f / 1024.0f) + EPS); } }
        { const float* cmk = q->cmk; const float* cmv = q->cmv; bf16* MKB = WSB(WS_MK); bf16* MVB = WSB(WS_MV);
          for (int it = blockIdx.x * 512 + tid; it < 2 * 262144; it += G * 512) { const int which = it / 262144, e = it % 262144, l = e / 131072, rem = e % 131072;
            const float* src = (which ? cmv : cmk) + (size_t)l * 1048576 + (size_t)rem * 8; bf16* dst = (which ? MVB : MKB) + (size_t)l * 24 * 65536 + 8 * 65536 + (size_t)rem * 8;
            const f32x4 a = *(const f32x4*)src, b = *(const f32x4*)(src + 4); *(v4u*)dst = mx::pk8(a, b); } }
        { const float* wsp = q->w_sp; bf16* WSPB = WSB(WS_WSP);
          for (int it = blockIdx.x * 512 + tid; it < 24576; it += G * 512) { const int t = (it % 2048) / 16, s0 = (it % 16) * 8; const float* src = wsp + (size_t)it * 8;
            f32x4 a = *(const f32x4*)src, b = *(const f32x4*)(src + 4);
#pragma unroll
            for (int e = 0; e < 4; ++e) { if (s0 + e > t) a[e] = 0.f; if (s0 + 4 + e > t) b[e] = 0.f; }
            *(v4u*)(WSPB + (size_t)it * 8) = mx::pk8(a, b); } }
    }
    xcd_barrier(bar);
    xcd_group_setup(bar);
#define GENV() volatile LAS unsigned* gst_ = (volatile LAS unsigned*)(lds + MISC_OFF) + 8; const int grp = __builtin_amdgcn_readfirstlane((int)gst_[4]), rank = __builtin_amdgcn_readfirstlane((int)gst_[5]), \
    GS = __builtin_amdgcn_readfirstlane((int)gst_[6]), nb = __builtin_amdgcn_readfirstlane((int)gst_[7]); (void)grp; (void)rank; (void)GS; (void)nb

    { ENV(); GENV();
        const bool early = rank & 1;
#define P1_SMALL() do { { sk::SkMemKV E{WSF(WS_RSM), WSB(WS_MK), WSB(WS_MV), q->out + O_MK, q->out + O_MV, 0}; sk::skinny_phase_k1024(lds + RING_OFF, WSB(WS_MB), WSB(WS_WMKV), 8, E, 8 * nb, 8 * nb * grp, rank, GS); } \
          { sk::SkInA E{WSF(WS_SS), WSB(WS_Q), WSB(WS_QM), (WS_K - WS_Q) / 2, q->out + O_KS, q->out + O_VS}; sk::skinny_phase_k1024(lds + RING_OFF, WSB(WS_XB) + (size_t)MP * D, WSB(WS_WINA), 40, E, nb, nb * grp, rank, GS); } } while (0)
        if (early) { P1_SMALL(); __syncthreads(); }
        { pg8::Gemm g{WSB(WS_XB), WSB(WS_WINA), MP, 2560, 1024}; pg8::LocalOrder S; S.init(16 * nb * grp, 16 * nb, 2560, GS, rank, (grp & 1) ? 5 : 0);
          rcs[128] = __int_as_float(-1); pg8::EpiInA E{pg8::RstdCache{rcs, WSF(WS_SS)}, WSB(WS_Q), WSB(WS_QM), (WS_K - WS_Q) / 2, q->out + O_KP, q->out + O_VP};
          pg8::gemm_phase<pg8::EpiInA, pg8::LocalOrder, true, true>(lds + RING_OFF, g, S, E); }
        __syncthreads();
        if (!early) P1_SMALL();
#undef P1_SMALL
    }
    grp_barrier(bar);

    for (int l = 0; l < 2; ++l) {
        if (l == 0) { ENV(); GENV();
            const mx::SbArgs SA{WSB(WS_Q), WSB(WS_K), WSB(WS_V), q->csk, q->csv, WSB(WS_OM)};
            for (int r = rank * NWAVES + wave; r < 24 * nb; r += GS * NWAVES) mx::sb_sample_unit(SA, wslot, 2 * nb * grp + r / 12, r % 12, lane);
            __syncthreads();
            { const int tot = 192 * nb, per = (tot + GS - 1) / GS, k0 = rank * per, k1 = k0 + per < tot ? k0 + per : tot; mx::sb_wg_units(SA, lds + RING_OFF, tot * grp + k0, tot * grp + k1, tid); }
        } else { ENV(); GENV();
            const int lgnb = nb == 1 ? 0 : 3;
            const mx::SgArgs GA{WSB(WS_Q), WSB(WS_K), WSB(WS_WSP), WSF(WS_SSV), q->g_sgu, q->b_sp, WSB(WS_OM), q->out + O_SV, 5 + lgnb, 32 * nb * grp, 1 + lgnb, 2 * nb * grp};
            { const int tot = 384 * nb, per = (tot + GS - 1) / GS, k0 = rank * per, k1 = k0 + per < tot ? k0 + per : tot; mx::sg_wg_units(GA, lds + RING_OFF, k0, k1, false, tid); }
            for (int u = rank; u < 24 * nb; u += GS) mx::sg_wg_units(GA, lds + RING_OFF, u, u + 1, true, tid);
        }
        __syncthreads();
        { ENV(); GENV();
            const mx::MaArgs MA{WSB(WS_QM), WSB(WS_MK) + (size_t)l * 24 * 65536, WSB(WS_MV) + (size_t)l * 24 * 65536, WSB(WS_OM)};
            for (int k = rank; k < 32 * nb; k += GS) { const int u = 32 * nb * grp + k, bm = u >> 3, b = bm >> 2; mx::ma_wg_unit(MA, lds + RING_OFF, (size_t)b * 4096 + (u & 7) * 512, b, bm & 3, 16, 32, tid); }
            { const int nsm = 8 * nb;
              for (int k = (GS >= nsm ? rank - (GS - nsm) : rank); k < nsm; k += GS) if (k >= 0) { const int qq = nsm * grp + k, b = qq >> 2; mx::ma_wg_unit(MA, lds + RING_OFF, (size_t)MP + 16 * b, 8 + b, qq & 3, 1, 16, tid); } }
        }
        grp_barrier(bar);
        { ENV(); GENV(); const bf16* W = WSB(WS_WOUT) + (size_t)l * 1024 * 1024; bf16* XB = WSB(WS_XB);
          const bool early = rank & 1;
#define OUT_SMALL() do { sk::SkResidT<false, false> E{XB + (size_t)MP * D, XB + (size_t)MP * D, WSF(WS_SS)}; sk::skinny_phase_k1024(lds + RING_OFF, WSB(WS_OM) + (size_t)MP * D, W, 16, E, nb, nb * grp, rank, GS); } while (0)
          if (early) { OUT_SMALL(); __syncthreads(); }
          { pg8::Gemm g{WSB(WS_OM), W, MP, 1024, 1024}; pg8::LocalOrder S; S.init(16 * nb * grp, 16 * nb, 1024, GS, rank);
            pg8::EpiResidT<false, false> E{XB, XB, WSF(WS_SS)};
            pg8::gemm_phase<pg8::EpiResidT<false, false>, pg8::LocalOrder, true, true>(lds + RING_OFF, g, S, E); }
          __syncthreads();
          if (!early) OUT_SMALL();
#undef OUT_SMALL
        }
        grp_barrier(bar);
        { ENV(); GENV(); const bf16* W = WSB(WS_WGU) + (size_t)l * 5632 * 1024;
          const bool early = rank & 1;
#define GU_SMALL() do { sk::SkGateUp E{WSF(WS_SS), WSB(WS_H)}; sk::skinny_phase_k1024(lds + RING_OFF, WSB(WS_XB) + (size_t)MP * D, W, 88, E, nb, nb * grp, rank, GS); } while (0)
          if (early) { GU_SMALL(); __syncthreads(); }
          { pg8::Gemm g{WSB(WS_XB), W, MP, 5632, 1024}; pg8::LocalOrder S; S.init(16 * nb * grp, 16 * nb, 5632, GS, rank);
            rcs[128] = __int_as_float(-1); pg8::EpiGateUp E{pg8::RstdCache{rcs, WSF(WS_SS)}, WSB(WS_H)};
            pg8::gemm_phase<pg8::EpiGateUp, pg8::LocalOrder, true, true>(lds + RING_OFF, g, S, E); }
          __syncthreads();
          if (!early) GU_SMALL();
#undef GU_SMALL
        }
        grp_barrier(bar);
        { ENV(); GENV(); const bf16* W = WSB(WS_WDN) + (size_t)l * 1024 * DFF; bf16* XB = WSB(WS_XB);
          const bool early = rank & 1;
#define DN_SMALL() do { sk::SkResidT<false, false> E{XB + (size_t)MP * D, XB + (size_t)MP * D, WSF(WS_SS)}; sk::skinny_phase_k2816(lds + RING_OFF, WSB(WS_H) + (size_t)MP * DFF, W, 16, E, nb, nb * grp, rank, GS); } while (0)
          if (early) { DN_SMALL(); __syncthreads(); }
          { pg8::Gemm g{WSB(WS_H), W, MP, 1024, DFF}; pg8::LocalOrder S; S.init(16 * nb * grp, 16 * nb, 1024, GS, rank);
            pg8::EpiResidT<false, false> E{XB, XB, WSF(WS_SS)};
            pg8::gemm_phase<pg8::EpiResidT<false, false>, pg8::LocalOrder, true, true>(lds + RING_OFF, g, S, E); }
          __syncthreads();
          if (!early) DN_SMALL();
#undef DN_SMALL
        }
        grp_barrier(bar);
        if (l == 0) {
            { ENV(); GENV();
              const int lo = GS / 2;
              { sk::SkInB E{WSF(WS_SS), WSB(WS_Q), WSB(WS_QM), (WS_K - WS_Q) / 2, WSF(WS_SSV)}; sk::skinny_phase_k1024(lds + RING_OFF, WSB(WS_XB) + (size_t)MP * D, WSB(WS_WINB), 28, E, nb, nb * grp, rank - lo, GS - lo); }
              { sk::SkMemKV E{WSF(WS_RSM), WSB(WS_MK), WSB(WS_MV), q->out + O_MK, q->out + O_MV, 1}; sk::skinny_phase_k1024(lds + RING_OFF, WSB(WS_MB), WSB(WS_WMKV), 8, E, 8 * nb, 8 * nb * grp, rank - lo, GS - lo); }
              __syncthreads();
              { pg8::Gemm g{WSB(WS_XB), WSB(WS_WINB), MP, 1792, 1024}; pg8::LocalOrder S; S.init(16 * nb * grp, 16 * nb, 1792, GS, rank);
                rcs[128] = __int_as_float(-1); pg8::EpiInB E{pg8::RstdCache{rcs, WSF(WS_SS)}, WSB(WS_Q), WSB(WS_QM), (WS_K - WS_Q) / 2, WSF(WS_SSV)};
                pg8::gemm_phase<pg8::EpiInB, pg8::LocalOrder, true, true>(lds + RING_OFF, g, S, E); } }
            grp_barrier(bar);
        }
    }
    { ENV(); GENV(); const bf16* XB = WSB(WS_XB); float* O = q->out + O_YP; const float* SS = WSF(WS_SS); const f32x4* gf = (const f32x4*)q->g_final + 2 * lane;
      unsigned* qw = (unsigned*)(ws + WS_CTL) + CW_FQ;
      volatile LAS unsigned* bc = (volatile LAS unsigned*)(lds + MISC_OFF) + 20;
      const int npr = 4096 * nb, ntot = npr + 32 * nb, nchunk = (ntot + 63) / 64, ngrp = 8 / nb;
      if (rank == 0 && tid == 0) { __builtin_amdgcn_fence(__ATOMIC_RELEASE, "agent"); asm volatile("s_waitcnt vmcnt(0)" ::: "memory");
          __hip_atomic_store(qw + 256 + 16 * grp, 1u, RLX_AGENT); }
      f32x4 gv[4];
#pragma unroll
      for (int j = 0; j < 2; ++j) { gv[2 * j] = gf[128 * j]; gv[2 * j + 1] = gf[128 * j + 1]; }
      for (int step = 0; step < ngrp; ++step) {
        int g = grp + step; if (g >= ngrp) g -= ngrp;
        if (step > 0) {
            if (tid == 0) { unsigned sp = 0u; while (__hip_atomic_load(qw + 256 + 16 * g, RLX_AGENT) == 0u) { __builtin_amdgcn_s_sleep(2); if (++sp > (1u << 22)) break; }
                __builtin_amdgcn_fence(__ATOMIC_ACQUIRE, "agent"); asm volatile("s_waitcnt vmcnt(0)" ::: "memory"); }
            __syncthreads(); }
        for (;;) {
            if (tid == 0) *bc = __hip_atomic_fetch_add(qw + 16 * g, 1u, RLX_AGENT);
            __syncthreads();
            const int chunk = (int)*bc;
            __syncthreads();
            if (chunk >= nchunk) break;
#pragma unroll 1
            for (int t = 0; t < 2; ++t) {
                const int i0 = chunk * 64 + wave * 8 + t * 4;
                int mrow[4]; float ssv[4]; v4u xr[4][2];
#pragma unroll
                for (int k = 0; k < 4; ++k) { const int i = i0 + k, ic = i < ntot ? i : ntot - 1; mrow[k] = ic < npr ? npr * g + ic : MP + 32 * nb * g + (ic - npr);
                    ssv[k] = lane < 16 ? SS[(size_t)mrow[k] * 16 + lane] : 0.f;
                    const GAS v4u* xp = (const GAS v4u*)(XB + (size_t)mrow[k] * D) + lane; xr[k][0] = xp[0]; xr[k][1] = xp[64]; }
#pragma unroll
                for (int k = 0; k < 4; ++k) { float s = ssv[k];
                    s += __shfl_xor(s, 1); s += __shfl_xor(s, 2); s += __shfl_xor(s, 4); s += __shfl_xor(s, 8);
                    s = __shfl(s, 0);
                    const float rs = __builtin_amdgcn_rsqf(s * (1.0f / 1024.0f) + EPS);
                    if (i0 + k < ntot) { GAS f32x4* orow = (GAS f32x4*)(O + (size_t)mrow[k] * D) + 2 * lane;
#pragma unroll
                        for (int j = 0; j < 2; ++j) { const v4u r = xr[k][j];
                            const f32x4 a = {__uint_as_float(r.x << 16), __uint_as_float(r.x & 0xffff0000u), __uint_as_float(r.y << 16), __uint_as_float(r.y & 0xffff0000u)};
                            const f32x4 b = {__uint_as_float(r.z << 16), __uint_as_float(r.z & 0xffff0000u), __uint_as_float(r.w << 16), __uint_as_float(r.w & 0xffff0000u)};
                            orow[128 * j] = a * rs * gv[2 * j]; orow[128 * j + 1] = b * rs * gv[2 * j + 1]; } } }
            }
        }
      } }
}

extern "C" void kernel_launch(void* const* d_in, const int* in_sizes, int n_in, void* d_out, int out_size, void* d_ws, size_t ws_size, hipStream_t stream) {
    static int grid = 0;
    if (grid == 0) {
        if (n_in != 21 || (size_t)out_size != O_END || ws_size < WS_END) { fprintf(stderr, "kernel_launch: unexpected shapes (n_in %d, out %d, ws %zu); nothing launched\n", n_in, out_size, ws_size); grid = -1; return; }
        int dev = 0, cus = 0, per_cu = 0;
        if (hipGetDevice(&dev) != hipSuccess || hipDeviceGetAttribute(&cus, hipDeviceAttributeMultiprocessorCount, dev) != hipSuccess) { grid = -1; return; }
        if (hipFuncSetAttribute((const void*)mk_fwd, hipFuncAttributeMaxDynamicSharedMemorySize, LDS_BYTES) != hipSuccess) { fprintf(stderr, "kernel_launch: hipFuncSetAttribute failed\n"); grid = -1; return; }
        if (hipOccupancyMaxActiveBlocksPerMultiprocessor(&per_cu, (const void*)mk_fwd, NWAVES * 64, LDS_BYTES) != hipSuccess || per_cu < 1) fprintf(stderr, "kernel_launch: occupancy query reports %d\n", per_cu);
        (void)hipGetLastError();
        grid = cus;
    }
    if (grid < 0) return;
    if (hipMemsetAsync((char*)d_ws + WS_CTL, 0, CTL_ZERO_BYTES, stream) != hipSuccess) return;
    Params p{};
    p.xp = (const float*)d_in[0]; p.xs = (const float*)d_in[1]; p.csk = (const float*)d_in[2]; p.csv = (const float*)d_in[3]; p.cmk = (const float*)d_in[4]; p.cmv = (const float*)d_in[5];
    p.memp = (const float*)d_in[6]; p.g_mix = (const float*)d_in[7]; p.w_in_a = (const float*)d_in[8]; p.w_in_b = (const float*)d_in[9]; p.w_sp = (const float*)d_in[10]; p.b_sp = (const float*)d_in[11];
    p.g_sgu = (const float*)d_in[12]; p.g_mem = (const float*)d_in[13]; p.w_mem_kv = (const float*)d_in[14]; p.w_out = (const float*)d_in[15]; p.g_ffn = (const float*)d_in[16];
    p.w_gate = (const float*)d_in[17]; p.w_up = (const float*)d_in[18]; p.w_down = (const float*)d_in[19]; p.g_final = (const float*)d_in[20];
    p.out = (float*)d_out; p.ws = (unsigned char*)d_ws;
    hipLaunchKernelGGL(mk_fwd, dim3(grid), dim3(NWAVES * 64), LDS_BYTES, stream, p);
    const hipError_t le = hipPeekAtLastError();
    if (le != hipSuccess) fprintf(stderr, "kernel_launch: launch failed: %s\n", hipGetErrorName(le));
}
```

```cpp
#include <hip/hip_runtime.h>
#include <hip/hip_bf16.h>
#include <cstdio>
#include <cstdint>
#include <cmath>
namespace pg8 {
#define PG8_LAS __attribute__((address_space(3)))
typedef unsigned short bf16_t;
typedef short bf16x8 __attribute__((ext_vector_type(8)));
typedef float f32x4 __attribute__((ext_vector_type(4)));
typedef unsigned u32x4 __attribute__((ext_vector_type(4)));
constexpr int BM = 256, BK = 64, HALF = 128, HTB = HALF * BK * 2  , STAGE_BYTES = 8 * HTB, NXCD = 8, WGM = 8;

__host__ __device__ __forceinline__ int lds_byte(int r, int c) { const int st = (r >> 4) * 2 + (c >> 5), rr = r & 15, cc = c & 31, ob = rr * 64 + cc * 2; return st * 1024 + (ob ^ (((ob >> 9) & 1) << 5)); }
__host__ __device__ __forceinline__ void stage_rc(int b, int& R, int& C) { const int st = b / 1024, sb = b % 1024, swz = sb ^ (((sb >> 9) & 1) << 5); R = (st >> 1) * 16 + swz / 64; C = (st & 1) * 32 + (swz % 64) / 2; }
__host__ __device__ __forceinline__ int perm32(int rho) { const int n = rho >> 4, i = rho & 15; return 8 * (i >> 2) + 4 * n + (i & 3); }

struct Unit { int pm, pn; };
struct Gemm { const bf16_t* A; const bf16_t* Bt; int M, N, K; };

struct StaticOrder {
    int nM, nN, nwg, G, c;
    __host__ __device__ void init(int M, int N, int G_, int c_) { nM = M / BM; nN = N / BM; nwg = nM * nN; G = G_; c = c_; }
    __host__ __device__ bool next(int i, Unit& u) const {
        const long L = (long)i * G + c; if (L >= nwg) return false;
        int wgid = (int)L; { const int q = nwg / NXCD, r = nwg % NXCD, xcd = wgid % NXCD, off = wgid / NXCD; wgid = (xcd < r ? xcd * (q + 1) : r * (q + 1) + (xcd - r) * q) + off; }
        const int nig = WGM * nN, gid = wgid / nig, fm = gid * WGM, gsz = (nM - fm) < WGM ? (nM - fm) : WGM;
        u.pm = fm + ((wgid % nig) % gsz); u.pn = (wgid % nig) / gsz; return true;
    }
    __device__ __forceinline__ void a_ready(const Unit&) const {}
    __device__ __forceinline__ void done(const Unit&) const {}
};
struct LocalOrder {
    int nM, nN, nwg, GS, r, pm0, rot;
    __host__ __device__ void init(int pm0_, int npanels, int N, int GS_, int r_, int rot_ = 0) { pm0 = pm0_; nM = npanels; nN = N / BM; nwg = nM * nN; GS = GS_; r = r_; rot = rot_; }
    __host__ __device__ bool next(int i, Unit& u) const {
        const int L = i * GS + r; if (L >= nwg) return false;
        const int nig = WGM * nN, gid = L / nig, rem = L - gid * nig;
        int pn = rem / WGM + rot; if (pn >= nN) pn -= nN;
        u.pm = pm0 + gid * WGM + (rem % WGM); u.pn = pn; return true;
    }
    __device__ __forceinline__ void a_ready(const Unit&) const {}
    __device__ __forceinline__ void done(const Unit&) const {}
};

typedef float f32x2 __attribute__((ext_vector_type(2)));
typedef __bf16 bf16x2_t __attribute__((ext_vector_type(2)));
__device__ __forceinline__ unsigned cvt_pk_bf16(float lo, float hi) { const f32x2 v = {lo, hi}; const bf16x2_t b = __builtin_convertvector(v, bf16x2_t); return __builtin_bit_cast(unsigned, b); }
__device__ __forceinline__ f32x2 gelu_pk(f32x2 v) {
    const f32x2 av = __builtin_elementwise_abs(v), d = av * 0.2316418882f + 1.0f;
    f32x2 t; t.x = __builtin_amdgcn_rcpf(d.x); t.y = __builtin_amdgcn_rcpf(d.y);
    f32x2 q = t * 0.5307027145f + (-0.7265760135f); q = q * t + 0.7107068705f; q = q * t + (-0.142248368f); q = q * t + 0.127414796f; q = q * t;
    const f32x2 s = (v * v) * (-0.72134752044f);
    f32x2 e; e.x = __builtin_amdgcn_exp2f(s.x); e.y = __builtin_amdgcn_exp2f(s.y);
    const f32x2 m = v * (q * e), r = v - m;
    f32x2 o; o.x = v.x < 0.f ? m.x : r.x; o.y = v.y < 0.f ? m.y : r.y; return o;
}

typedef float f32x2 __attribute__((ext_vector_type(2)));
constexpr int MP = 32768, MTOT = 33024;
constexpr float RMS_EPS = 1e-6f;
__device__ __forceinline__ u32x4 pack8(const f32x4 v0, const f32x4 v1) { u32x4 w; w.x = cvt_pk_bf16(v0[0], v0[1]); w.y = cvt_pk_bf16(v0[2], v0[3]); w.z = cvt_pk_bf16(v1[0], v1[1]); w.w = cvt_pk_bf16(v1[2], v1[3]); return w; }
template <int NP> __device__ __forceinline__ float row_rstd(const float* ss, int row, float inv_n) {
    const f32x4* p = (const f32x4*)(ss + (size_t)row * NP); float s = 0.f;
#pragma unroll
    for (int i = 0; i < NP / 4; ++i) { const f32x4 v = p[i]; s += (v[0] + v[1]) + (v[2] + v[3]); }
    return __builtin_amdgcn_rsqf(s * inv_n + RMS_EPS);
}
__device__ __forceinline__ float fast_sigmoid(float x) { return __builtin_amdgcn_rcpf(1.0f + __builtin_amdgcn_exp2f(-1.4426950408889634f * x)); }
__device__ __forceinline__ float gelu_tanh(float x) { const float y = 0.7978845608028654f * (x + 0.044715f * x * x * x); return x * fast_sigmoid(2.0f * y); }

struct RstdCache {
    PG8_LAS float* slice; const float* ss;
    __device__ __forceinline__ void prepare(int pm, int wr, int lane) const {
        PG8_LAS int* tag = (PG8_LAS int*)(slice + 128);
        if (__builtin_amdgcn_readfirstlane(*tag) == pm) return;
        f32x4 v[2][4];
#pragma unroll
        for (int k = 0; k < 2; ++k) { const int idx = lane + 64 * k, row = pm * BM + (idx >> 6) * HALF + wr * 64 + (idx & 63); const f32x4* p = (const f32x4*)(ss + (size_t)row * 16);
#pragma unroll
            for (int i = 0; i < 4; ++i) v[k][i] = p[i]; }
#pragma unroll
        for (int k = 0; k < 2; ++k) { float s = 0.f;
#pragma unroll
            for (int i = 0; i < 4; ++i) s += (v[k][i][0] + v[k][i][1]) + (v[k][i][2] + v[k][i][3]);
            slice[lane + 64 * k] = __builtin_amdgcn_rsqf(s * (1.0f / 1024.0f) + RMS_EPS); }
        *tag = pm;
    }
    __device__ __forceinline__ float get(int ai, int m, int fr) const { return slice[ai * 64 + m * 16 + fr]; }
};
struct EpiInA {
    static constexpr bool PERM = true, AFTER_DRAIN = false;
    RstdCache rc; bf16_t *Q, *QM; size_t qkv_stride; float *kout_p, *vout_p;
    __device__ __forceinline__ void operator()(const f32x4 (&acc)[2][2][4][2], const Unit& u, int wr, int wc, int fr, int fq) const {
        const int t = u.pn / 3, colt = (u.pn - 3 * t) * BM + wc * 32 + 8 * fq;
        bf16_t* dst = t == 3 ? QM : Q + (size_t)t * qkv_stride; const int ld = t == 3 ? 256 : 768;
        float* fo = t == 1 ? kout_p : vout_p;
        const bool wf = (t == 1 || t == 2);
        rc.prepare(u.pm, wr, fq * 16 + fr);
#pragma unroll
        for (int ai = 0; ai < 2; ++ai)
#pragma unroll
            for (int m = 0; m < 4; ++m) { const int row = u.pm * BM + ai * HALF + wr * 64 + m * 16 + fr; const float rs = rc.get(ai, m, fr);
#pragma unroll
                for (int bj = 0; bj < 2; ++bj) { const f32x4 v0 = acc[ai][bj][m][0] * rs, v1 = acc[ai][bj][m][1] * rs; const int col = colt + bj * HALF;
                    *(u32x4*)(dst + (size_t)row * ld + col) = pack8(v0, v1);
                    if (wf) {
                        f32x4 A, B;
#pragma unroll
                        for (int c = 0; c < 4; ++c) { const auto s1 = __builtin_amdgcn_permlane16_swap(__float_as_uint(v0[c]), __float_as_uint(v1[c]), false, false);
                            const auto s2 = __builtin_amdgcn_permlane32_swap(s1[0], s1[1], false, false); A[c] = __uint_as_float(s2[0]); B[c] = __uint_as_float(s2[1]); }
                        float* f = fo + (size_t)row * 768 + (col - 8 * fq) + 4 * fq; __builtin_nontemporal_store(A, (f32x4*)f); __builtin_nontemporal_store(B, (f32x4*)(f + 16)); } } }
    }
};
template <bool BASE_F32, bool OUT_F32> struct EpiResidT {
    static constexpr bool PERM = true, AFTER_DRAIN = false;
    const void* base; void* out; float* ss;
    __device__ __forceinline__ void operator()(const f32x4 (&acc)[2][2][4][2], const Unit& u, int wr, int wc, int fr, int fq) const {
        const int col0 = u.pn * BM + wc * 32 + 8 * fq;
#pragma unroll
        for (int ai = 0; ai < 2; ++ai) {
            f32x4 b[4][2][2];
#pragma unroll
            for (int m = 0; m < 4; ++m) { const size_t off = (size_t)(u.pm * BM + ai * HALF + wr * 64 + m * 16 + fr) * 1024 + col0;
#pragma unroll
                for (int bj = 0; bj < 2; ++bj) {
                    if (BASE_F32) { b[m][bj][0] = *(const f32x4*)((const float*)base + off + bj * HALF); b[m][bj][1] = *(const f32x4*)((const float*)base + off + bj * HALF + 4); }
                    else { const u32x4 r = *(const u32x4*)((const bf16_t*)base + off + bj * HALF);
                        b[m][bj][0] = (f32x4){__uint_as_float(r.x << 16), __uint_as_float(r.x & 0xffff0000u), __uint_as_float(r.y << 16), __uint_as_float(r.y & 0xffff0000u)};
                        b[m][bj][1] = (f32x4){__uint_as_float(r.z << 16), __uint_as_float(r.z & 0xffff0000u), __uint_as_float(r.w << 16), __uint_as_float(r.w & 0xffff0000u)}; } } }
            asm volatile("" ::: "memory");
#pragma unroll
            for (int m = 0; m < 4; ++m) { const int row = u.pm * BM + ai * HALF + wr * 64 + m * 16 + fr; const size_t off = (size_t)row * 1024 + col0; f32x2 q2 = {0.f, 0.f};
#pragma unroll
                for (int bj = 0; bj < 2; ++bj) { const f32x4 v0 = acc[ai][bj][m][0] + b[m][bj][0], v1 = acc[ai][bj][m][1] + b[m][bj][1];
                    if (OUT_F32) { *(f32x4*)((float*)out + off + bj * HALF) = v0; *(f32x4*)((float*)out + off + bj * HALF + 4) = v1; }
                    else *(u32x4*)((bf16_t*)out + off + bj * HALF) = pack8(v0, v1);
                    const f32x2 p0 = {v0[0], v0[1]}, p1 = {v0[2], v0[3]}, p2 = {v1[0], v1[1]}, p3 = {v1[2], v1[3]};
                    q2 = p0 * p0 + q2; q2 = p1 * p1 + q2; q2 = p2 * p2 + q2; q2 = p3 * p3 + q2; }
                float s = q2.x + q2.y;
                s += __shfl_xor(s, 16); s += __shfl_xor(s, 32);
                if (fq == 0) ss[(size_t)row * 16 + u.pn * 4 + wc] = s; }
        }
    }
};
struct EpiGateUp {
    static constexpr bool PERM = true, AFTER_DRAIN = false;
    RstdCache rc; bf16_t* H;
    __device__ __forceinline__ void operator()(const f32x4 (&acc)[2][2][4][2], const Unit& u, int wr, int wc, int fr, int fq) const {
        const int col = u.pn * HALF + wc * 32 + 8 * fq;
        rc.prepare(u.pm, wr, fq * 16 + fr);
#pragma unroll
        for (int ai = 0; ai < 2; ++ai)
#pragma unroll
            for (int m = 0; m < 4; ++m) { const int row = u.pm * BM + ai * HALF + wr * 64 + m * 16 + fr; const float rs = rc.get(ai, m, fr), c1 = -1.4426950408889634f * rs, c2 = rs * rs;
                u32x4 w;
#pragma unroll
                for (int n = 0; n < 2; ++n)
#pragma unroll
                    for (int p = 0; p < 2; ++p) { const f32x2 g = {acc[ai][0][m][n][2 * p], acc[ai][0][m][n][2 * p + 1]}, up = {acc[ai][1][m][n][2 * p], acc[ai][1][m][n][2 * p + 1]};
                        const f32x2 t = g * c1; f32x2 e; e.x = __builtin_amdgcn_exp2f(t.x); e.y = __builtin_amdgcn_exp2f(t.y);
                        const f32x2 d = e + 1.0f; f32x2 r; r.x = __builtin_amdgcn_rcpf(d.x); r.y = __builtin_amdgcn_rcpf(d.y);
                        const f32x2 h = ((g * up) * c2) * r;
                        w[2 * n + p] = cvt_pk_bf16(h.x, h.y); }
                *(u32x4*)(H + (size_t)row * 2816 + col) = w; }
    }
};
struct EpiInB {
    static constexpr bool PERM = true, AFTER_DRAIN = false;
    RstdCache rc; bf16_t *U, *QM; size_t ugv_stride; float* ssv;
    __device__ __forceinline__ void operator()(const f32x4 (&acc)[2][2][4][2], const Unit& u, int wr, int wc, int fr, int fq) const {
        const int t = u.pn / 3, pl = u.pn - 3 * t, colt = pl * BM + wc * 32 + 8 * fq;
        bf16_t* dst = t == 2 ? QM : U + (size_t)t * ugv_stride; const int ld = t == 2 ? 256 : 768;
        rc.prepare(u.pm, wr, fq * 16 + fr);
#pragma unroll
        for (int ai = 0; ai < 2; ++ai)
#pragma unroll
            for (int m = 0; m < 4; ++m) { const int row = u.pm * BM + ai * HALF + wr * 64 + m * 16 + fr; const float rs = rc.get(ai, m, fr); float s = 0.f;
#pragma unroll
                for (int bj = 0; bj < 2; ++bj) { f32x4 v0 = acc[ai][bj][m][0] * rs, v1 = acc[ai][bj][m][1] * rs;
                    if (t < 2) {
                        f32x2 q2 = {0.f, 0.f};
#pragma unroll
                        for (int p = 0; p < 4; ++p) { f32x2 x; if (p < 2) { x.x = v0[2 * p]; x.y = v0[2 * p + 1]; } else { x.x = v1[2 * p - 4]; x.y = v1[2 * p - 3]; }
                            const f32x2 a = x * ((x * x) * (-0.10294324f) + (-2.3022082f)); f32x2 e; e.x = __builtin_amdgcn_exp2f(a.x); e.y = __builtin_amdgcn_exp2f(a.y);
                            const f32x2 d = e + 1.0f; f32x2 r; r.x = __builtin_amdgcn_rcpf(d.x); r.y = __builtin_amdgcn_rcpf(d.y);
                            const f32x2 y = x * r; q2 = y * y + q2;
                            if (p < 2) { v0[2 * p] = y.x; v0[2 * p + 1] = y.y; } else { v1[2 * p - 4] = y.x; v1[2 * p - 3] = y.y; } }
                        s += q2.x + q2.y; }
                    *(u32x4*)(dst + (size_t)row * ld + colt + bj * HALF) = pack8(v0, v1); }
                if (t == 1) { s += __shfl_xor(s, 16); s += __shfl_xor(s, 32); if (fq == 0) ssv[(size_t)row * 12 + pl * 4 + wc] = s; } }
    }
};
template <class Epi, class Sched, bool ALIGN_EPI = false, bool SP2 = false>
__device__ __forceinline__ void gemm_phase(PG8_LAS unsigned char* lds, const Gemm g, const Sched& S, const Epi& E) {
    int tid = threadIdx.x; asm volatile("" : "+v"(tid));
    const int wid = __builtin_amdgcn_readfirstlane(tid >> 6), lane = tid & 63, wr = wid >> 2, wc = wid & 3, fr = lane & 15, fq = lane >> 4;
    const int K = g.K, nt = K / BK;
    unsigned voffA[2], voffB[2];
#pragma unroll
    for (int i = 0; i < 2; ++i) { int R, C; stage_rc(tid * 16 + i * 8192, R, C); const int Rb = Epi::PERM ? ((R & ~31) + perm32(R & 31)) : R;
        voffA[i] = (unsigned)(R * K + C) * 2u; voffB[i] = (unsigned)(Rb * K + C) * 2u; }
    const size_t kstep = (size_t)(BK * 2);
    const size_t hstep = (size_t)HALF * K * 2;
    const size_t tstep = 2 * hstep;
    const unsigned ldsw = (unsigned)wid * 1024u;
    const int aoff = lds_byte(wr * 64 + fr, fq * 8), boff = lds_byte(wc * 32 + fr, fq * 8);
#define PG8_SA(b, h) (((b) * 2 + (h)) * HTB)
#define PG8_SB(b, h) ((4 + (b) * 2 + (h)) * HTB)
#define PG8_STAGE(bufoff, gbase, voff) do { _Pragma("unroll") for (int _i = 0; _i < 2; ++_i) \
        __builtin_amdgcn_global_load_lds((const unsigned*)((const char*)(gbase) + (voff)[_i]), (PG8_LAS unsigned*)(lds + (bufoff) + ldsw + _i * 8192), 16, 0, 0); } while (0)
#define PG8_LDA(dst, b, h) do { _Pragma("unroll") for (int m = 0; m < 4; ++m) _Pragma("unroll") for (int k = 0; k < 2; ++k) dst[m][k] = *(const PG8_LAS bf16x8*)(lds + PG8_SA(b, h) + aoff + m * 2048 + k * 1024); } while (0)
#define PG8_LDB(dst, b, h) do { _Pragma("unroll") for (int n = 0; n < 2; ++n) _Pragma("unroll") for (int k = 0; k < 2; ++k) dst[n][k] = *(const PG8_LAS bf16x8*)(lds + PG8_SB(b, h) + boff + n * 2048 + k * 1024); } while (0)
#define PG8_MMA(ai, bj, At, Bt) do { __builtin_amdgcn_s_setprio(1); _Pragma("unroll") for (int m = 0; m < 4; ++m) _Pragma("unroll") for (int n = 0; n < 2; ++n) _Pragma("unroll") for (int k = 0; k < 2; ++k) \
        acc[ai][bj][m][n] = __builtin_amdgcn_mfma_f32_16x16x32_bf16(Bt[n][k], At[m][k], acc[ai][bj][m][n], 0, 0, 0); __builtin_amdgcn_s_setprio(0); } while (0)
#define PG8_WAIT_V(n) asm volatile("s_waitcnt vmcnt(" #n ")" ::: "memory")
#define PG8_WAIT_L(n) asm volatile("s_waitcnt lgkmcnt(" #n ")" ::: "memory")
#define PG8_BAR __builtin_amdgcn_s_barrier()
#define PG8_SCHED __builtin_amdgcn_sched_barrier(0)
    Unit cur, nxt; int ui = 0;
    if (!S.next(0, cur)) return;
    f32x4 acc[2][2][4][2];
#pragma unroll
    for (int a = 0; a < 2; ++a)
#pragma unroll
        for (int b = 0; b < 2; ++b)
#pragma unroll
            for (int m = 0; m < 4; ++m)
#pragma unroll
                for (int n = 0; n < 2; ++n) acc[a][b][m][n] = (f32x4){0.f, 0.f, 0.f, 0.f};
    bf16x8 At[4][2], B0[2][2], B1[2][2];
    const char* cA = (const char*)g.A + (size_t)cur.pm * tstep; const char* cB = (const char*)g.Bt + (size_t)cur.pn * tstep;
    S.a_ready(cur);
    if constexpr (SP2) {
        PG8_STAGE(PG8_SB(0, 0), cB, voffB); PG8_STAGE(PG8_SB(0, 1), cB + hstep, voffB); PG8_STAGE(PG8_SA(0, 0), cA, voffA); PG8_STAGE(PG8_SA(0, 1), cA + hstep, voffA);
        if (wr == 1) PG8_BAR;
        PG8_WAIT_V(2); PG8_BAR;
        PG8_STAGE(PG8_SB(1, 0), cB + kstep, voffB); PG8_STAGE(PG8_SA(1, 0), cA + kstep, voffA); PG8_STAGE(PG8_SB(1, 1), cB + hstep + kstep, voffB);
        PG8_WAIT_V(6); PG8_BAR;
    } else {
        PG8_STAGE(PG8_SB(0, 0), cB, voffB); PG8_STAGE(PG8_SA(0, 0), cA, voffA); PG8_STAGE(PG8_SB(0, 1), cB + hstep, voffB); PG8_STAGE(PG8_SA(0, 1), cA + hstep, voffA);
        if (wr == 1) PG8_BAR;
        PG8_WAIT_V(4); PG8_BAR;
        PG8_STAGE(PG8_SB(1, 0), cB + kstep, voffB); PG8_STAGE(PG8_SA(1, 0), cA + kstep, voffA); PG8_STAGE(PG8_SB(1, 1), cB + hstep + kstep, voffB);
        PG8_WAIT_V(6); PG8_BAR;
    }
    for (;;) {
        const bool has_next = S.next(ui + 1, nxt);
        const char* nA = has_next ? (const char*)g.A + (size_t)nxt.pm * tstep : cA; const char* nB = has_next ? (const char*)g.Bt + (size_t)nxt.pn * tstep : cB;
        for (int t = 0; t < nt; t += 2) {
            const bool last = (t == nt - 2);
            const char* a1 = cA + (size_t)(t + 1) * kstep;
            const char* a2 = last ? nA : cA + (size_t)(t + 2) * kstep; const char* b2 = last ? nB : cB + (size_t)(t + 2) * kstep;
            const char* a3 = a2 + kstep; const char* b3 = b2 + kstep;
            if (last && has_next) S.a_ready(nxt);
            if constexpr (SP2) {
            PG8_LDB(B0, 0, 0); PG8_LDB(B1, 0, 1); PG8_SCHED; PG8_LDA(At, 0, 0); PG8_STAGE(PG8_SA(1, 1), a1 + hstep, voffA);
            PG8_WAIT_V(8); PG8_WAIT_L(0); PG8_BAR; PG8_MMA(0, 0, At, B0); PG8_MMA(0, 1, At, B1); PG8_BAR; PG8_SCHED;
            PG8_LDA(At, 0, 1); PG8_STAGE(PG8_SB(0, 0), b2, voffB); PG8_STAGE(PG8_SB(0, 1), b2 + hstep, voffB); PG8_STAGE(PG8_SA(0, 0), a2, voffA);
            PG8_WAIT_V(8); PG8_WAIT_L(0); PG8_BAR; PG8_MMA(1, 0, At, B0); PG8_MMA(1, 1, At, B1); PG8_BAR; PG8_SCHED;
            PG8_LDB(B0, 1, 0); PG8_LDB(B1, 1, 1); PG8_SCHED; PG8_LDA(At, 1, 0); PG8_STAGE(PG8_SA(0, 1), a2 + hstep, voffA);
            PG8_WAIT_V(8); PG8_WAIT_L(0); PG8_BAR; PG8_MMA(0, 0, At, B0); PG8_MMA(0, 1, At, B1); PG8_BAR; PG8_SCHED;
            PG8_LDA(At, 1, 1); PG8_STAGE(PG8_SB(1, 0), b3, voffB); PG8_STAGE(PG8_SB(1, 1), b3 + hstep, voffB); PG8_STAGE(PG8_SA(1, 0), a3, voffA);
            PG8_WAIT_V(8); PG8_WAIT_L(0); PG8_BAR; PG8_MMA(1, 0, At, B0); PG8_MMA(1, 1, At, B1); PG8_BAR; PG8_SCHED;
            } else {
            PG8_LDB(B0, 0, 0); PG8_SCHED; PG8_LDA(At, 0, 0); PG8_STAGE(PG8_SA(1, 1), a1 + hstep, voffA);
            PG8_WAIT_L(8); PG8_BAR; PG8_WAIT_L(0); PG8_MMA(0, 0, At, B0); PG8_BAR; PG8_SCHED;
            PG8_LDB(B1, 0, 1); PG8_STAGE(PG8_SB(0, 0), b2, voffB);
            PG8_BAR; PG8_WAIT_L(0); PG8_MMA(0, 1, At, B1); PG8_BAR;
            PG8_LDA(At, 0, 1); PG8_STAGE(PG8_SA(0, 0), a2, voffA);
            PG8_BAR; PG8_WAIT_L(0); PG8_MMA(1, 0, At, B0); PG8_BAR; PG8_SCHED;
            PG8_STAGE(PG8_SB(0, 1), b2 + hstep, voffB);
            PG8_WAIT_V(6); PG8_BAR; PG8_MMA(1, 1, At, B1); PG8_BAR;
            PG8_LDB(B0, 1, 0); PG8_SCHED; PG8_LDA(At, 1, 0); PG8_STAGE(PG8_SA(0, 1), a2 + hstep, voffA);
            PG8_WAIT_L(8); PG8_BAR; PG8_WAIT_L(0); PG8_MMA(0, 0, At, B0); PG8_BAR; PG8_SCHED;
            PG8_LDB(B1, 1, 1); PG8_STAGE(PG8_SB(1, 0), b3, voffB);
            PG8_BAR; PG8_WAIT_L(0); PG8_MMA(0, 1, At, B1); PG8_BAR;
            PG8_LDA(At, 1, 1); PG8_STAGE(PG8_SA(1, 0), a3, voffA);
            PG8_BAR; PG8_WAIT_L(0); PG8_MMA(1, 0, At, B0); PG8_BAR; PG8_SCHED;
            PG8_STAGE(PG8_SB(1, 1), b3 + hstep, voffB);
            PG8_WAIT_V(6); PG8_BAR; PG8_MMA(1, 1, At, B1); PG8_BAR;
            }
        }
        if constexpr (ALIGN_EPI) { if (wr == 0) PG8_BAR; }
        if constexpr (!Epi::AFTER_DRAIN) { E(acc, cur, wr, wc, fr, fq); S.done(cur); }
        if (!has_next) break;
#pragma unroll
        for (int a = 0; a < 2; ++a)
#pragma unroll
            for (int b = 0; b < 2; ++b)
#pragma unroll
                for (int m = 0; m < 4; ++m)
#pragma unroll
                    for (int n = 0; n < 2; ++n) acc[a][b][m][n] = (f32x4){0.f, 0.f, 0.f, 0.f};
        cur = nxt; cA = nA; cB = nB; ++ui;
        if constexpr (ALIGN_EPI) { if (wr == 1) PG8_BAR; }
    }
    PG8_WAIT_V(0);
    if constexpr (!ALIGN_EPI) { if (wr == 0) PG8_BAR; }
    PG8_BAR;
    if constexpr (Epi::AFTER_DRAIN) { E.fused(acc, cur, wr, wc, fr, fq, lds, wid, lane); S.done(cur); }
#undef PG8_SA
#undef PG8_SB
#undef PG8_STAGE
#undef PG8_LDA
#undef PG8_LDB
#undef PG8_MMA
#undef PG8_WAIT_V
#undef PG8_WAIT_L
#undef PG8_BAR
#undef PG8_SCHED
}
}
namespace mx {
#define MX_LAS __attribute__((address_space(3)))
typedef unsigned short bf16_t;
typedef short bf16x8 __attribute__((ext_vector_type(8)));
typedef short s16x4 __attribute__((ext_vector_type(4)));
typedef float f32x16 __attribute__((ext_vector_type(16)));
typedef float f32x4 __attribute__((ext_vector_type(4)));
typedef unsigned u32x4 __attribute__((ext_vector_type(4)));
typedef float f32x2_t __attribute__((ext_vector_type(2))); typedef __bf16 bf16x2_t __attribute__((ext_vector_type(2)));
typedef MX_LAS unsigned char* lptr; typedef const MX_LAS unsigned char* lcptr;
#define MX_MFMA(a, b, c) __builtin_amdgcn_mfma_f32_32x32x16_bf16((a), (b), (c), 0, 0, 0)
constexpr int WAVE_LDS = 16384, KIMG = 0, VIMG = 8192;
constexpr float SB_EXIT = 9.0949470177e-13f;
__device__ __forceinline__ int crow(int r, int hi) { return (r & 3) + 8 * (r >> 2) + 4 * hi; }
__device__ __forceinline__ unsigned cvtpk(float lo, float hi) { f32x2_t v = {lo, hi}; bf16x2_t b = __builtin_convertvector(v, bf16x2_t); return __builtin_bit_cast(unsigned, b); }
__device__ __forceinline__ unsigned short f2bf(float f) { return (unsigned short)(cvtpk(f, 0.f) & 0xffffu); }
__device__ __forceinline__ float bf2f(unsigned short h) { return __uint_as_float(((unsigned)h) << 16); }
__device__ __forceinline__ s16x4 vtr(lcptr p) { typedef short v4i16_t __attribute__((ext_vector_type(4))); return __builtin_bit_cast(s16x4, __builtin_amdgcn_ds_read_tr16_b64_v4i16((MX_LAS v4i16_t*)p)); }
__device__ __forceinline__ u32x4 pk8(const f32x4 a, const f32x4 b) { u32x4 w; w.x = cvtpk(a[0], a[1]); w.y = cvtpk(a[2], a[3]); w.z = cvtpk(b[0], b[1]); w.w = cvtpk(b[2], b[3]); return w; }

template <bool DOK, bool DOV> __device__ __forceinline__ void load_tile_bf16(lptr slot, const bf16_t* Kg, const bf16_t* Vg, int pitch, int lane, int nvalid) {
    if (DOK) { const bool ok = lane < nvalid; const bf16_t* kr = Kg + (size_t)(ok ? lane : 0) * pitch; u32x4 kv[8];
#pragma unroll
        for (int c = 0; c < 8; ++c) kv[c] = *(const u32x4*)(kr + c * 8);
#pragma unroll
        for (int c = 0; c < 8; ++c) *(MX_LAS u32x4*)(slot + KIMG + c * 1024 + lane * 16) = ok ? kv[c] : (u32x4){0u, 0u, 0u, 0u}; }
    if (DOV) { u32x4 vv[8];
#pragma unroll
        for (int p = 0; p < 8; ++p) { const int row = 16 * (p & 3) + (lane >> 2); const bool ok = row < nvalid; vv[p] = *(const u32x4*)(Vg + (size_t)(ok ? row : 0) * pitch + (p >> 2) * 32 + (lane & 3) * 8); if (!ok) vv[p] = (u32x4){0u, 0u, 0u, 0u}; }
#pragma unroll
        for (int p = 0; p < 8; ++p) *(MX_LAS u32x4*)(slot + VIMG + p * 1024 + lane * 16) = vv[p]; }
}
__device__ __forceinline__ void load_tile_f32(lptr slot, const float* Kg, const float* Vg, int pitch, int lane) {
    { const float* kr = Kg + (size_t)lane * pitch;
#pragma unroll
        for (int c = 0; c < 8; ++c) { const f32x4 a = *(const f32x4*)(kr + c * 8), b = *(const f32x4*)(kr + c * 8 + 4); *(MX_LAS u32x4*)(slot + KIMG + c * 1024 + lane * 16) = pk8(a, b); } }
#pragma unroll
    for (int p = 0; p < 8; ++p) { const float* vr = Vg + (size_t)(16 * (p & 3) + (lane >> 2)) * pitch + (p >> 2) * 32 + (lane & 3) * 8;
        const f32x4 a = *(const f32x4*)vr, b = *(const f32x4*)(vr + 4); *(MX_LAS u32x4*)(slot + VIMG + p * 1024 + lane * 16) = pk8(a, b); }
}
template <bool SWZ = false> __device__ __forceinline__ void qkt(f32x16& p0, f32x16& p1, lcptr slot, const bf16x8 (&qr)[4], int r32, int hi) {
    f32x16 z;
#pragma unroll
    for (int r = 0; r < 16; ++r) z[r] = 0.f;
    p0 = z; p1 = z;
#pragma unroll
    for (int d0 = 0; d0 < 4; ++d0) { const int c = 2 * d0 + hi; lcptr kb = slot + KIMG + c * 1024 + (SWZ ? ((r32 & 24) | ((r32 ^ c) & 7)) : r32) * 16;
        const bf16x8 b0 = *(const MX_LAS bf16x8*)kb, b1 = *(const MX_LAS bf16x8*)(kb + 512);
        p0 = MX_MFMA(b0, qr[d0], p0); p1 = MX_MFMA(b1, qr[d0], p1); }
}
__device__ __forceinline__ void pv(f32x16 (&o)[2], lcptr slot, const f32x16& p0, const f32x16& p1, int lane, int hi) {
    lcptr vp = slot + VIMG + ((lane >> 4) & 1) * 32 + (lane & 3) * 8 + (4 * hi + ((lane & 15) >> 2)) * 64;
    u32x4 pw[4];
    pw[0] = (u32x4){cvtpk(p0[0], p0[1]), cvtpk(p0[2], p0[3]), cvtpk(p0[4], p0[5]), cvtpk(p0[6], p0[7])};
    pw[1] = (u32x4){cvtpk(p0[8], p0[9]), cvtpk(p0[10], p0[11]), cvtpk(p0[12], p0[13]), cvtpk(p0[14], p0[15])};
    pw[2] = (u32x4){cvtpk(p1[0], p1[1]), cvtpk(p1[2], p1[3]), cvtpk(p1[4], p1[5]), cvtpk(p1[6], p1[7])};
    pw[3] = (u32x4){cvtpk(p1[8], p1[9]), cvtpk(p1[10], p1[11]), cvtpk(p1[12], p1[13]), cvtpk(p1[14], p1[15])};
#pragma unroll
    for (int d0 = 0; d0 < 2; ++d0)
#pragma unroll
        for (int ks = 0; ks < 4; ++ks) { const s16x4 lo = vtr(vp + d0 * 4096 + ks * 1024), hh = vtr(vp + d0 * 4096 + ks * 1024 + 512);
            const bf16x8 vf = (bf16x8){lo[0], lo[1], lo[2], lo[3], hh[0], hh[1], hh[2], hh[3]};
            o[d0] = MX_MFMA(__builtin_bit_cast(bf16x8, pw[ks]), vf, o[d0]); }
}
template <bool MASK> __device__ __forceinline__ void sb_half(f32x16& p, float& S, int hi, int kbase, int qrel) {
    float k[16];
#pragma unroll
    for (int r = 0; r < 16; ++r) { const float z = __builtin_amdgcn_fmed3f(p[r], -126.f, 126.f), e = __builtin_amdgcn_exp2f(-z);   float bt = __builtin_amdgcn_rcpf(1.0f + e), kp = e * bt;
        if (MASK) { if (kbase + crow(r, hi) >= qrel) { bt = 0.f; kp = 1.f; } } p[r] = bt; k[r] = kp; }
    float GE[4], GO[4];
#pragma unroll
    for (int i = 0; i < 4; ++i) { const float g = (k[4 * i] * k[4 * i + 1]) * (k[4 * i + 2] * k[4 * i + 3]);
        auto rr = __builtin_amdgcn_permlane32_swap(__float_as_uint(g), __float_as_uint(g), false, false); GE[i] = __uint_as_float(rr[0]); GO[i] = __uint_as_float(rr[1]); }
    float own[4];
#pragma unroll
    for (int i = 3; i >= 0; --i) { const float So = S; S = S * GO[i]; const float Se = S; S = S * GE[i]; own[i] = hi ? So : Se; }
#pragma unroll
    for (int i = 0; i < 4; ++i) { float rest = own[i]; const float a3 = p[4 * i + 3] * rest; rest *= k[4 * i + 3]; const float a2 = p[4 * i + 2] * rest; rest *= k[4 * i + 2]; const float a1 = p[4 * i + 1] * rest; rest *= k[4 * i + 1];
        const float a0 = p[4 * i] * rest; p[4 * i] = a0; p[4 * i + 1] = a1; p[4 * i + 2] = a2; p[4 * i + 3] = a3; }
}
template <bool MASK, bool SWZ = false> __device__ __forceinline__ void sb_tile(f32x16 (&o)[2], float& carry, lcptr slot, const bf16x8 (&qr)[4], int lane, int r32, int hi, int qrel) {
    f32x16 p0, p1; qkt<SWZ>(p0, p1, slot, qr, r32, hi);
    sb_half<MASK>(p1, carry, hi, 32, qrel);
    sb_half<MASK>(p0, carry, hi, 0, qrel);
    pv(o, slot, p0, p1, lane, hi);
}
__device__ __forceinline__ void store_o(const f32x16 (&o)[2], bf16_t* OM, size_t row0, int col0, int r32, int hi, int nrows) {
#pragma unroll
    for (int r = 0; r < 16; ++r) { const int q = crow(r, hi); if (q < nrows) { bf16_t* p = OM + (row0 + q) * 1024 + col0 + r32; p[0] = f2bf(o[0][r]); p[32] = f2bf(o[1][r]); } }
}
__device__ __forceinline__ void store_o_staged(const f32x16 (&o)[2], lptr stg, bf16_t* OM, size_t row0, int col0, int lane, int nrows) {
    const int r32 = lane & 31, hi = lane >> 5;
#pragma unroll
    for (int r = 0; r < 16; ++r) { const int q = crow(r, hi); *(MX_LAS bf16_t*)(stg + (q * 64 + r32) * 2) = f2bf(o[0][r]); *(MX_LAS bf16_t*)(stg + (q * 64 + 32 + r32) * 2) = f2bf(o[1][r]); }
#pragma unroll
    for (int i = 0; i < 4; ++i) { const int row = i * 8 + (lane >> 3), ch = lane & 7; const u32x4 v = *(const MX_LAS u32x4*)(stg + (row * 64 + ch * 8) * 2);
        if (row < nrows) *(u32x4*)(OM + (row0 + row) * 1024 + col0 + ch * 8) = v;
        asm volatile("" ::: "memory"); }
}
struct SbArgs { const bf16_t *Q, *K, *V; const float *cK, *cV; bf16_t* OM; };
__device__ __forceinline__ void sb_sample_unit(const SbArgs& A, lptr slot, int b, int h, int lane) {
    asm volatile("" : "+v"(lane));
    const int r32 = lane & 31, hi = lane >> 5, qi = r32 & 15; const size_t row0 = (size_t)pg8::MP + b * 16;
    bf16x8 qr[4]; { const bf16_t* qp = A.Q + (row0 + qi) * 768 + h * 64 + hi * 8;
#pragma unroll
        for (int d0 = 0; d0 < 4; ++d0) qr[d0] = *(const bf16x8*)(qp + d0 * 16); }
    f32x16 o[2];
#pragma unroll
    for (int r = 0; r < 16; ++r) { o[0][r] = 0.f; o[1][r] = 0.f; }
    float carry = 1.0f;
    { const size_t toff = row0 * 768 + h * 64; load_tile_bf16<true, true>(slot, A.K + toff, A.V + toff, 768, lane, 16);
      sb_tile<true>(o, carry, slot, qr, lane, r32, hi, qi); }
    for (int T = 63; T >= 0; --T) {
        if (__all(carry < SB_EXIT)) break;
        const size_t toff = ((size_t)b * 4096 + 64 * T) * 768 + h * 64;
        load_tile_f32(slot, A.cK + toff, A.cV + toff, 768, lane);
        sb_tile<false>(o, carry, slot, qr, lane, r32, hi, 0);
    }
    store_o(o, A.OM, row0, h * 64, r32, hi, 16);
}
constexpr int SB_WIN = 5;
struct SbPre { u32x4 k[SB_WIN], v[SB_WIN]; };
__device__ __forceinline__ void sb_prefetch(SbPre& P, const SbArgs& A, int u, int tid) {
    const int bh = u >> 4, qb = u & 15, b = bh / 12, h = bh - 12 * b, Tlo = qb == 0 ? 0 : 4 * qb - (SB_WIN - 4), nt = qb == 0 ? 4 : SB_WIN;
    const size_t base = ((size_t)b * 4096 + (tid >> 3)) * 768 + h * 64 + (tid & 7) * 8;
#pragma unroll
    for (int s = 0; s < SB_WIN; ++s) { const int T = Tlo + (s < nt ? s : nt - 1); const size_t off = base + (size_t)T * 64 * 768; P.k[s] = *(const u32x4*)(A.K + off); P.v[s] = *(const u32x4*)(A.V + off); }
}
__device__ __forceinline__ void sb_stage_piece(lptr slot, const u32x4 kk, const u32x4 vv, int tid) {
    const int row = tid >> 3, c = tid & 7;
    *(MX_LAS u32x4*)(slot + KIMG + c * 1024 + ((row & 56) | ((row ^ c) & 7)) * 16) = kk;
    *(MX_LAS u32x4*)(slot + VIMG + (c >> 2) * 4096 + row * 64 + (c & 3) * 16) = vv;
}
__device__ __forceinline__ void sb_wg_units(const SbArgs& A, lptr lds, int u0, int u1, int tid) {
    asm volatile("" : "+v"(tid));
    const int lane = tid & 63, wave = __builtin_amdgcn_readfirstlane(tid >> 6), r32 = lane & 31, hi = lane >> 5;
    if (u0 >= u1) return;
    MX_LAS unsigned* flags = (MX_LAS unsigned*)(lds + SB_WIN * WAVE_LDS);
    SbPre P; sb_prefetch(P, A, u0, tid);
    for (int u = u0; u < u1; ++u) {
        const int bh = u >> 4, qb = u & 15, b = bh / 12, h = bh - 12 * b, Tlo = qb == 0 ? 0 : 4 * qb - (SB_WIN - 4);
        __syncthreads();
#pragma unroll
        for (int s = 0; s < SB_WIN; ++s) sb_stage_piece(lds + s * WAVE_LDS, P.k[s], P.v[s], tid);
        __syncthreads();
        const size_t rowq = (size_t)b * 4096 + 256 * qb + 32 * wave;
        bf16x8 qr[4]; { const bf16_t* qp = A.Q + (rowq + r32) * 768 + h * 64 + hi * 8;
#pragma unroll
            for (int d0 = 0; d0 < 4; ++d0) qr[d0] = *(const bf16x8*)(qp + d0 * 16); }
        asm volatile("" ::: "memory");
        sb_prefetch(P, A, u + 1 < u1 ? u + 1 : u, tid);
        f32x16 o[2];
#pragma unroll
        for (int r = 0; r < 16; ++r) { o[0][r] = 0.f; o[1][r] = 0.f; }
        float carry = 1.0f; const int Td = 4 * qb + (wave >> 1); bool done = false;
        for (int T = Td; T >= Tlo; --T) {
            lcptr slot = lds + (T - Tlo) * WAVE_LDS;
            if (T == Td) sb_tile<true, true>(o, carry, slot, qr, lane, r32, hi, 32 * (wave & 1) + r32); else sb_tile<false, true>(o, carry, slot, qr, lane, r32, hi, 0);
            if (__all(carry < SB_EXIT)) { done = true; break; }
        }
        for (int T = Tlo - 1; ; --T) {
            const bool need = !done && T >= 0;
            if (lane == 0) flags[wave] = need ? 1u : 0u;
            __syncthreads();
            unsigned any = 0u;
#pragma unroll
            for (int w = 0; w < 8; ++w) any |= flags[w];
            if (!__builtin_amdgcn_readfirstlane(any)) break;
            { const size_t off = ((size_t)b * 4096 + (size_t)T * 64 + (tid >> 3)) * 768 + h * 64 + (tid & 7) * 8; sb_stage_piece(lds, *(const u32x4*)(A.K + off), *(const u32x4*)(A.V + off), tid); }
            __syncthreads();
            if (need) { sb_tile<false, true>(o, carry, lds, qr, lane, r32, hi, 0); if (__all(carry < SB_EXIT)) done = true; }
        }
        store_o(o, A.OM, rowq, h * 64, r32, hi, 32);
    }
    __syncthreads();
}
struct MaArgs { const bf16_t *QM, *MK, *MV; bf16_t* OM; };
__device__ __forceinline__ void ma_wg_unit(const MaArgs& A, lptr lds, size_t row0, int bb, int mh, int nblk, int nrows, int tid) {
    asm volatile("" : "+v"(tid));
    const int lane = tid & 63, wave = __builtin_amdgcn_readfirstlane(tid >> 6), r32 = lane & 31, hi = lane >> 5;
    { const bf16_t* Kb = A.MK + (size_t)bb * 65536 + mh * 64; const bf16_t* Vb = A.MV + (size_t)bb * 65536 + mh * 64; u32x4 kv[4], vv[4];
#pragma unroll
      for (int i = 0; i < 4; ++i) { const int idx = tid + 512 * i, row = idx >> 3; kv[i] = *(const u32x4*)(Kb + (size_t)row * 256 + (idx & 7) * 8); vv[i] = *(const u32x4*)(Vb + (size_t)row * 256 + (idx & 7) * 8); }
#pragma unroll
      for (int i = 0; i < 4; ++i) { const int idx = tid + 512 * i, row = idx >> 3, c = idx & 7, rr = row & 63;
          *(MX_LAS u32x4*)(lds + (row >> 6) * WAVE_LDS + KIMG + c * 1024 + ((rr & 56) | ((rr ^ c) & 7)) * 16) = kv[i];
          *(MX_LAS u32x4*)(lds + (row >> 6) * WAVE_LDS + VIMG + (c >> 2) * 4096 + rr * 64 + (c & 3) * 16) = vv[i]; } }
    __syncthreads();
    for (int blk = wave; blk < nblk; blk += 8) {
        const size_t rowq = row0 + 32 * blk; const int qi = nrows >= 32 ? r32 : (r32 & 15);
        bf16x8 qr[4]; { const bf16_t* qp = A.QM + (rowq + qi) * 256 + mh * 64 + hi * 8;
#pragma unroll
            for (int d0 = 0; d0 < 4; ++d0) qr[d0] = *(const bf16x8*)(qp + d0 * 16); }
        float m = -INFINITY;
        for (int T = 0; T < 4; ++T) { f32x16 p0, p1; qkt<true>(p0, p1, lds + T * WAVE_LDS, qr, r32, hi);
#pragma unroll
            for (int r = 0; r < 16; ++r) m = __builtin_fmaxf(m, __builtin_fmaxf(p0[r], p1[r])); }
        { auto rr = __builtin_amdgcn_permlane32_swap(__float_as_uint(m), __float_as_uint(m), false, false); m = __builtin_fmaxf(__uint_as_float(rr[0]), __uint_as_float(rr[1])); }
        float l = 0.f; f32x16 o[2];
#pragma unroll
        for (int r = 0; r < 16; ++r) { o[0][r] = 0.f; o[1][r] = 0.f; }
        for (int T = 0; T < 4; ++T) { f32x16 p0, p1; qkt<true>(p0, p1, lds + T * WAVE_LDS, qr, r32, hi);
#pragma unroll
            for (int r = 0; r < 16; ++r) { p0[r] = __builtin_amdgcn_exp2f(p0[r] - m); p1[r] = __builtin_amdgcn_exp2f(p1[r] - m); l += p0[r] + p1[r]; }
            pv(o, lds + T * WAVE_LDS, p0, p1, lane, hi); }
        { auto rr = __builtin_amdgcn_permlane32_swap(__float_as_uint(l), __float_as_uint(l), false, false); l = __uint_as_float(rr[0]) + __uint_as_float(rr[1]); }
        { MX_LAS float* sc = (MX_LAS float*)(lds + 4 * WAVE_LDS) + wave * 32; if (hi == 0) sc[r32] = 1.0f / l;
#pragma unroll
          for (int r = 0; r < 16; ++r) { const float f = sc[crow(r, hi)]; o[0][r] *= f; o[1][r] *= f; } }
        store_o_staged(o, lds + 4 * WAVE_LDS + 1024 + wave * 4096, A.OM, rowq, 768 + mh * 64, lane, nrows);
    }
    __syncthreads();
}
struct SgArgs { const bf16_t *U, *GV, *WSP; const float *ssv, *g_sgu, *b_sp; bf16_t* OM; float* vout; int gsh_p, ch0, gsh_s, s0; };
constexpr int SG_W = 0, SG_V = 32768, SG_U = 49152, SG_O = 65536, SG_LDS = 81920;
typedef unsigned sg_u32x2 __attribute__((ext_vector_type(2)));
struct SgPre { u32x4 raw[2], uraw[2]; f32x4 sv[2][3]; f32x4 gd[4]; float bias; };
__device__ __forceinline__ void sg_decode(const SgArgs& A, int u, bool sample, int& g, size_t& row0) { const int sh = sample ? A.gsh_s : A.gsh_p, c = u & ((1 << sh) - 1); g = u >> sh; row0 = sample ? (size_t)pg8::MP + 16 * (A.s0 + c) : (size_t)(A.ch0 + c) * 128; }
__device__ __forceinline__ void sg_prefetch(SgPre& P, const SgArgs& A, int u, bool sample, int tid) {
    int g; size_t row0; sg_decode(A, u, sample, g, row0); const int nrows = sample ? 16 : 128;
#pragma unroll
    for (int i = 0; i < 2; ++i) { const int idx = tid + 512 * i, s = idx >> 3, c = idx & 7; const size_t row = row0 + (s < nrows ? s : 0);
        P.raw[i] = *(const u32x4*)(A.GV + row * 768 + g * 64 + c * 8); P.uraw[i] = *(const u32x4*)(A.U + row * 768 + g * 64 + c * 8); const f32x4* sp = (const f32x4*)(A.ssv + row * 12);
#pragma unroll
        for (int j = 0; j < 3; ++j) P.sv[i][j] = sp[j]; }
    { const int lane = tid & 63, wave = tid >> 6, t = 32 * (wave >> 1) + (lane & 31); const bool tok = t < nrows; const size_t row = row0 + (tok ? t : 0);
      const float* gp = A.g_sgu + g * 64 + 32 * (wave & 1) + 4 * (lane >> 5);
#pragma unroll
      for (int i = 0; i < 4; ++i) P.gd[i] = *(const f32x4*)(gp + 8 * i);
      P.bias = A.b_sp[g * 128 + (tok ? t : 0)]; }
}
__device__ __forceinline__ void sg_restage_w(const SgArgs& A, lptr lds, int g, int tid, int npieces) {
    const bf16_t* wg = A.WSP + (size_t)g * 16384; u32x4 w[4];
#pragma unroll
    for (int i = 0; i < 4; ++i) w[i] = *(const u32x4*)(wg + (tid + 512 * (i < npieces ? i : 0)) * 8);
#pragma unroll
    for (int i = 0; i < 4; ++i) if (i < npieces) { const int idx = tid + 512 * i, t = idx >> 4, c = idx & 15; *(MX_LAS u32x4*)(lds + SG_W + t * 256 + ((c ^ (t & 15)) * 16)) = w[i]; }
}
struct SgState { int gcur; int have_prev; size_t prow0; int pg; int pnrows; };
__device__ __forceinline__ void sg_store_out(const SgState& S, const SgArgs& A, lptr lds, int tid) {
#pragma unroll
    for (int i = 0; i < 2; ++i) { const int idx = tid + 512 * i, s = idx >> 3, c = idx & 7;
        if (s < S.pnrows) *(u32x4*)(A.OM + (S.prow0 + s) * 1024 + S.pg * 64 + c * 8) = *(const MX_LAS u32x4*)(lds + SG_O + s * 128 + ((c ^ ((s >> 1) & 7)) * 16)); }
}
template <bool CHECK_G> __device__ __forceinline__ void sg_unit_body(SgPre& P, SgState& S, const SgArgs& A, lptr lds, int u, int u1, bool sample, int tid, int lane, int wave) {
    const int r32 = lane & 31, hi = lane >> 5, tb = wave >> 1, dh = wave & 1, nrows = sample ? 16 : 128;
    int g; size_t row0; sg_decode(A, u, sample, g, row0);
    __syncthreads();
    if (S.have_prev) sg_store_out(S, A, lds, tid);
    if (CHECK_G && g != S.gcur) { S.gcur = g;
        sg_restage_w(A, lds, g, tid, sample ? 1 : 4); }
#pragma unroll
    for (int i = 0; i < 2; ++i) { const int idx = tid + 512 * i, s = idx >> 3, c = idx & 7; const u32x4 raw = P.raw[i];
        float ssum = 0.f;
#pragma unroll
        for (int j = 0; j < 3; ++j) { const f32x4 v = P.sv[i][j]; ssum += (v[0] + v[1]) + (v[2] + v[3]); }
        const float rs = s < nrows ? __builtin_amdgcn_rsqf(ssum * (1.0f / 768.0f) + pg8::RMS_EPS) : 0.f;
        f32x4 a, b2; a[0] = __uint_as_float(raw.x << 16); a[1] = __uint_as_float(raw.x & 0xffff0000u); a[2] = __uint_as_float(raw.y << 16); a[3] = __uint_as_float(raw.y & 0xffff0000u);
        b2[0] = __uint_as_float(raw.z << 16); b2[1] = __uint_as_float(raw.z & 0xffff0000u); b2[2] = __uint_as_float(raw.w << 16); b2[3] = __uint_as_float(raw.w & 0xffff0000u);
        a = a * rs; b2 = b2 * rs;
        *(MX_LAS u32x4*)(lds + SG_V + (c >> 2) * 8192 + s * 64 + (c & 3) * 16) = pk8(a, b2);
        *(MX_LAS u32x4*)(lds + SG_U + s * 128 + ((c ^ ((s >> 1) & 7)) * 16)) = P.uraw[i];
        if (sample && s < nrows) { const float* gp = A.g_sgu + g * 64 + c * 8; const f32x4 ga = *(const f32x4*)gp, gb = *(const f32x4*)(gp + 4);
            float* vo = A.vout + ((row0 - pg8::MP) + s) * 768 + g * 64 + c * 8; *(f32x4*)vo = a * ga; *(f32x4*)(vo + 4) = b2 * gb; } }
    __syncthreads();
    const f32x4 (&gd)[4] = P.gd; const float bias = P.bias;
    if (32 * tb < nrows) {
        const int t = 32 * tb + r32;
        f32x16 acc;
#pragma unroll
        for (int r = 0; r < 16; ++r) acc[r] = 0.f;
        lcptr wp = lds + SG_W + t * 256; lcptr vp = lds + SG_V + dh * 8192 + ((lane >> 4) & 1) * 32 + (lane & 3) * 8 + (8 * hi + ((lane & 15) >> 2)) * 64;
        const int nks = sample ? 1 : 2 * tb + 2;
        for (int ks = 0; ks < nks; ++ks) { const bf16x8 wa = *(const MX_LAS bf16x8*)(wp + (((2 * ks + hi) ^ (t & 15)) * 16));
            const s16x4 lo = vtr(vp + ks * 1024), hh = vtr(vp + ks * 1024 + 256);
            const bf16x8 vf = (bf16x8){lo[0], lo[1], lo[2], lo[3], hh[0], hh[1], hh[2], hh[3]};
            acc = MX_MFMA(vf, wa, acc); }
        {
#pragma unroll
            for (int i = 0; i < 4; ++i) { const int off = t * 128 + (((4 * dh + i) ^ ((t >> 1) & 7)) * 16) + 8 * hi; const sg_u32x2 uu = *(const MX_LAS sg_u32x2*)(lds + SG_U + off);
                const float u0f = __uint_as_float(uu.x << 16), u1f = __uint_as_float(uu.x & 0xffff0000u), u2f = __uint_as_float(uu.y << 16), u3f = __uint_as_float(uu.y & 0xffff0000u);
                sg_u32x2 w; w.x = cvtpk(u0f * (gd[i][0] * acc[4 * i] + bias), u1f * (gd[i][1] * acc[4 * i + 1] + bias)); w.y = cvtpk(u2f * (gd[i][2] * acc[4 * i + 2] + bias), u3f * (gd[i][3] * acc[4 * i + 3] + bias));
                *(MX_LAS sg_u32x2*)(lds + SG_O + off) = w; } }
    }
    S.have_prev = 1; S.prow0 = row0; S.pg = g; S.pnrows = nrows;
    sg_prefetch(P, A, u + 2 < u1 ? u + 2 : u1 - 1, sample, tid);
}
__device__ __forceinline__ void sg_wg_units(const SgArgs& A, lptr lds, int u0, int u1, bool sample, int tid) {
    asm volatile("" : "+v"(tid));
    const int lane = tid & 63, wave = __builtin_amdgcn_readfirstlane(tid >> 6);
    if (u0 >= u1) return;
    SgState S; S.gcur = -1; S.have_prev = 0; S.prow0 = 0; S.pg = 0; S.pnrows = 0;
    const int gshift = sample ? A.gsh_s : A.gsh_p;
    bool even = ((u1 - u0) & 1) == 0;
    for (int g = u0 >> gshift; even && (g << gshift) < u1; ++g) { const int a = (g << gshift) > u0 ? (g << gshift) : u0, b = ((g + 1) << gshift) < u1 ? ((g + 1) << gshift) : u1; if ((b - a) & 1) even = false; }
    if (even) {
        SgPre PA, PB; sg_prefetch(PA, A, u0, sample, tid); sg_prefetch(PB, A, u0 + 1, sample, tid);
        int u = u0;
        while (u < u1) {
            const int g = u >> gshift; int se = (g + 1) << gshift; if (se > u1) se = u1;
            __syncthreads();
            sg_restage_w(A, lds, g, tid, 4);
            for (; u < se; u += 2) { sg_unit_body<false>(PA, S, A, lds, u, u1, sample, tid, lane, wave); sg_unit_body<false>(PB, S, A, lds, u + 1, u1, sample, tid, lane, wave); }
        }
    } else {
        SgPre P;
        for (int u = u0; u < u1; ++u) { sg_prefetch(P, A, u, sample, tid); sg_unit_body<true>(P, S, A, lds, u, u1, sample, tid, lane, wave); }
    }
    __syncthreads();
    if (S.have_prev) sg_store_out(S, A, lds, tid);
    __syncthreads();
}
#undef MX_MFMA
}
namespace sk {
using mx::bf16_t; using mx::bf16x8; using mx::f32x16; using mx::f32x4; using mx::u32x4; using mx::cvtpk;
typedef unsigned u32x2 __attribute__((ext_vector_type(2)));
constexpr int MP = 32768;
__device__ __forceinline__ float rstd16(const float* ss, int row) { return pg8::row_rstd<16>(ss, row, 1.0f / 1024.0f); }
#define SK_GROUP(a, i) (f32x4){a[4 * (i)], a[4 * (i) + 1], a[4 * (i) + 2], a[4 * (i) + 3]}
__device__ __forceinline__ void sk_pin(float& x) { asm volatile("" : "+v"(x)); }
__device__ __forceinline__ void sk_pin(f32x4& x) { asm volatile("" : "+v"(x)); }
__device__ __forceinline__ u32x2 pk4(const f32x4 v) { u32x2 w; w.x = cvtpk(v[0], v[1]); w.y = cvtpk(v[2], v[3]); return w; }
struct SkInA {
    const float* ss; bf16_t *Q, *QM; size_t qkv_stride; float *kout_s, *vout_s;
    __device__ __forceinline__ void wrows(int cu, int& r0, int& r1) const { r0 = 64 * cu; r1 = 64 * cu + 32; }
    typedef float Pre;
    static __device__ __forceinline__ void pin(Pre& p) { sk_pin(p); }
    __device__ __forceinline__ Pre pre(int tb, int cu, int r32, int hi) const { return rstd16(ss, MP + tb * 32 + r32); }
    __device__ __forceinline__ void operator()(const f32x16& a0, const f32x16& a1, int tb, int cu, int r32, int hi, const Pre& rs) const {
        const int n0 = 64 * cu, t = n0 / 768, colw = n0 - 768 * t + 4 * hi; const int tok = tb * 32 + r32, row = MP + tok;
        bf16_t* dst = (t == 3 ? QM + (size_t)row * 256 : Q + (size_t)t * qkv_stride + (size_t)row * 768) + colw;
        float* fo = (t == 1 ? kout_s : vout_s) + (size_t)tok * 768 + colw; const bool wf = (t == 1 || t == 2);
#pragma unroll
        for (int i = 0; i < 4; ++i) { const f32x4 v0 = SK_GROUP(a0, i) * rs, v1 = SK_GROUP(a1, i) * rs;
            *(u32x2*)(dst + 8 * i) = pk4(v0); *(u32x2*)(dst + 32 + 8 * i) = pk4(v1);
            if (wf) { *(f32x4*)(fo + 8 * i) = v0; *(f32x4*)(fo + 32 + 8 * i) = v1; } }
    }
};
template <bool BASE_F32, bool OUT_F32> struct SkResidT {
    const void* base_s; void* out_s; float* ss;
    __device__ __forceinline__ void wrows(int cu, int& r0, int& r1) const { r0 = 64 * cu; r1 = 64 * cu + 32; }
    struct Pre { f32x4 b0[4], b1[4]; };
    static __device__ __forceinline__ void pin(Pre& p) {
#pragma unroll
        for (int i = 0; i < 4; ++i) { sk_pin(p.b0[i]); sk_pin(p.b1[i]); } }
    __device__ __forceinline__ Pre pre(int tb, int cu, int r32, int hi) const { Pre p; const size_t off = (size_t)(tb * 32 + r32) * 1024 + 64 * cu + 4 * hi;
#pragma unroll
        for (int i = 0; i < 4; ++i) {
            if (BASE_F32) { p.b0[i] = *(const f32x4*)((const float*)base_s + off + 8 * i); p.b1[i] = *(const f32x4*)((const float*)base_s + off + 32 + 8 * i); }
            else { const u32x2 r0 = *(const u32x2*)((const bf16_t*)base_s + off + 8 * i), r1 = *(const u32x2*)((const bf16_t*)base_s + off + 32 + 8 * i);
                p.b0[i] = (f32x4){__uint_as_float(r0.x << 16), __uint_as_float(r0.x & 0xffff0000u), __uint_as_float(r0.y << 16), __uint_as_float(r0.y & 0xffff0000u)};
                p.b1[i] = (f32x4){__uint_as_float(r1.x << 16), __uint_as_float(r1.x & 0xffff0000u), __uint_as_float(r1.y << 16), __uint_as_float(r1.y & 0xffff0000u)}; } }
        return p; }
    __device__ __forceinline__ void operator()(const f32x16& a0, const f32x16& a1, int tb, int cu, int r32, int hi, const Pre& P) const {
        const int tok = tb * 32 + r32; const size_t off = (size_t)tok * 1024 + 64 * cu + 4 * hi; float s = 0.f;
#pragma unroll
        for (int i = 0; i < 4; ++i) { const f32x4 v0 = SK_GROUP(a0, i) + P.b0[i], v1 = SK_GROUP(a1, i) + P.b1[i];
            if (OUT_F32) { *(f32x4*)((float*)out_s + off + 8 * i) = v0; *(f32x4*)((float*)out_s + off + 32 + 8 * i) = v1; }
            else { *(u32x2*)((bf16_t*)out_s + off + 8 * i) = pk4(v0); *(u32x2*)((bf16_t*)out_s + off + 32 + 8 * i) = pk4(v1); }
            s += (v0[0] * v0[0] + v0[1] * v0[1]) + (v0[2] * v0[2] + v0[3] * v0[3]) + (v1[0] * v1[0] + v1[1] * v1[1]) + (v1[2] * v1[2] + v1[3] * v1[3]); }
        { auto rr = __builtin_amdgcn_permlane32_swap(__float_as_uint(s), __float_as_uint(s), false, false); s = __uint_as_float(rr[0]) + __uint_as_float(rr[1]); }
        if (hi == 0) ss[(size_t)(MP + tok) * 16 + cu] = s;
    }
};
struct SkGateUp {
    const float* ss; bf16_t* H;
    __device__ __forceinline__ void wrows(int cu, int& r0, int& r1) const { r0 = 256 * (cu >> 2) + 32 * (cu & 3); r1 = r0 + 128; }
    typedef float Pre;
    static __device__ __forceinline__ void pin(Pre& p) { sk_pin(p); }
    __device__ __forceinline__ Pre pre(int tb, int cu, int r32, int hi) const { return rstd16(ss, MP + tb * 32 + r32); }
    __device__ __forceinline__ void operator()(const f32x16& a0, const f32x16& a1, int tb, int cu, int r32, int hi, const Pre& rs) const {
        const int row = MP + tb * 32 + r32; bf16_t* dst = H + (size_t)row * 2816 + 32 * cu + 4 * hi;
#pragma unroll
        for (int i = 0; i < 4; ++i) { const f32x4 g = SK_GROUP(a0, i) * rs, up = SK_GROUP(a1, i) * rs; f32x4 h;
#pragma unroll
            for (int e = 0; e < 4; ++e) h[e] = g[e] * pg8::fast_sigmoid(g[e]) * up[e];
            *(u32x2*)(dst + 8 * i) = pk4(h); }
    }
};
struct SkInB {
    const float* ss; bf16_t *U, *QM; size_t ugv_stride; float* ssv;
    __device__ __forceinline__ void wrows(int cu, int& r0, int& r1) const { r0 = 64 * cu; r1 = 64 * cu + 32; }
    typedef float Pre;
    static __device__ __forceinline__ void pin(Pre& p) { sk_pin(p); }
    __device__ __forceinline__ Pre pre(int tb, int cu, int r32, int hi) const { return rstd16(ss, MP + tb * 32 + r32); }
    __device__ __forceinline__ void operator()(const f32x16& a0, const f32x16& a1, int tb, int cu, int r32, int hi, const Pre& rs) const {
        const int n0 = 64 * cu, t = n0 / 768, colw = n0 - 768 * t + 4 * hi; const int row = MP + tb * 32 + r32;
        bf16_t* dst = (t == 2 ? QM + (size_t)row * 256 : U + (size_t)t * ugv_stride + (size_t)row * 768) + colw; float s = 0.f;
#pragma unroll
        for (int i = 0; i < 4; ++i) { f32x4 v0 = SK_GROUP(a0, i) * rs, v1 = SK_GROUP(a1, i) * rs;
            if (t < 2) {
#pragma unroll
                for (int e = 0; e < 4; ++e) { v0[e] = pg8::gelu_tanh(v0[e]); v1[e] = pg8::gelu_tanh(v1[e]); }
                s += (v0[0] * v0[0] + v0[1] * v0[1]) + (v0[2] * v0[2] + v0[3] * v0[3]) + (v1[0] * v1[0] + v1[1] * v1[1]) + (v1[2] * v1[2] + v1[3] * v1[3]); }
            *(u32x2*)(dst + 8 * i) = pk4(v0); *(u32x2*)(dst + 32 + 8 * i) = pk4(v1); }
        if (t == 1) { auto rr = __builtin_amdgcn_permlane32_swap(__float_as_uint(s), __float_as_uint(s), false, false); s = __uint_as_float(rr[0]) + __uint_as_float(rr[1]);
            if (hi == 0) ssv[(size_t)row * 12 + (n0 - 768) / 64] = s; }
    }
};
struct SkMemKV {
    const float* rsm; bf16_t *MK, *MV; float *ko, *vo; int l;
    __device__ __forceinline__ void wrows(int cu, int& r0, int& r1) const { r0 = l * 512 + 64 * cu; r1 = r0 + 32; }
    typedef float Pre;
    static __device__ __forceinline__ void pin(Pre& p) { sk_pin(p); }
    __device__ __forceinline__ Pre pre(int tb, int cu, int r32, int hi) const { return rsm[tb * 32 + r32]; }
    __device__ __forceinline__ void operator()(const f32x16& a0, const f32x16& a1, int tb, int cu, int r32, int hi, const Pre& rs) const {
        const int row = tb * 32 + r32; const bool isv = cu >= 4; const int colw = 64 * (cu & 3) + 4 * hi;
        bf16_t* dst = (isv ? MV : MK) + (size_t)l * 24 * 65536 + (size_t)row * 256 + colw; float* fo = (isv ? vo : ko) + (size_t)l * 2048 * 256 + (size_t)row * 256 + colw;
#pragma unroll
        for (int i = 0; i < 4; ++i) { const f32x4 v0 = SK_GROUP(a0, i) * rs, v1 = SK_GROUP(a1, i) * rs;
            *(u32x2*)(dst + 8 * i) = pk4(v0); *(u32x2*)(dst + 32 + 8 * i) = pk4(v1); *(f32x4*)(fo + 8 * i) = v0; *(f32x4*)(fo + 32 + 8 * i) = v1; }
    }
};
template <class Epi> __device__ __forceinline__ void skinny_phase(MX_LAS unsigned char* lds, const bf16_t* X, const bf16_t* Wt, int K, int ncu, const Epi& E, int ntb = 8, int wg0 = 0) {
    int tid = threadIdx.x; asm volatile("" : "+v"(tid));
    const int wave = __builtin_amdgcn_readfirstlane(tid >> 6), lane = tid & 63, r32 = lane & 31, hi = lane >> 5;
    MX_LAS float* red = (MX_LAS float*)lds;
    const int kper = K >> 3, nst = kper >> 4;
    if ((int)blockIdx.x < wg0) return;
    for (int u = blockIdx.x - wg0; u < ntb * ncu; u += gridDim.x - wg0) {
        const int tb = u % ntb, cu = u / ntb; int wr0, wr1; E.wrows(cu, wr0, wr1);
        const bf16_t* xp = X + (size_t)(tb * 32 + r32) * K + wave * kper + hi * 8;
        const bf16_t* w0 = Wt + (size_t)(wr0 + r32) * K + wave * kper + hi * 8; const bf16_t* w1 = Wt + (size_t)(wr1 + r32) * K + wave * kper + hi * 8;
        typename Epi::Pre pre = {}; if (wave == 0) pre = E.pre(tb, cu, r32, hi);
        f32x16 a0, a1;
#pragma unroll
        for (int r = 0; r < 16; ++r) { a0[r] = 0.f; a1[r] = 0.f; }
#pragma unroll 8
        for (int s = 0; s < nst; ++s) { const bf16x8 xf = *(const bf16x8*)(xp + 16 * s), f0 = *(const bf16x8*)(w0 + 16 * s), f1 = *(const bf16x8*)(w1 + 16 * s);
            a0 = __builtin_amdgcn_mfma_f32_32x32x16_bf16(f0, xf, a0, 0, 0, 0); a1 = __builtin_amdgcn_mfma_f32_32x32x16_bf16(f1, xf, a1, 0, 0, 0); }
#pragma unroll
        for (int r = 0; r < 16; ++r) { red[(wave * 32 + r) * 64 + lane] = a0[r]; red[(wave * 32 + 16 + r) * 64 + lane] = a1[r]; }
        __syncthreads();
        {
            MX_LAS float* fin = red + 8 * 32 * 64;
#pragma unroll
            for (int j = 0; j < 4; ++j) { const int reg = 4 * wave + j; float s0 = 0.f;
#pragma unroll
                for (int w = 0; w < 8; ++w) s0 += red[(w * 32 + reg) * 64 + lane];
                fin[reg * 64 + lane] = s0; }
        }
        __syncthreads();
        if (wave == 0) {
            MX_LAS const float* fin = red + 8 * 32 * 64;
#pragma unroll
            for (int r = 0; r < 16; ++r) { a0[r] = fin[r * 64 + lane]; a1[r] = fin[(16 + r) * 64 + lane]; }
            E(a0, a1, tb, cu, r32, hi, pre);
        }
        __syncthreads();
    }
}
template <class Epi> __device__ __forceinline__ void skinny_phase_k1024(MX_LAS unsigned char* lds, const bf16_t* X, const bf16_t* Wt, int ncu, const Epi& E, int ntb, int tb0, int first, int stride) {
    int tid = threadIdx.x; asm volatile("" : "+v"(tid));
    const int wave = __builtin_amdgcn_readfirstlane(tid >> 6), lane = tid & 63, r32 = lane & 31, hi = lane >> 5;
    constexpr int K = 1024, TILE = 96 * 128;
    MX_LAS unsigned char* tile = lds + wave * TILE;
    MX_LAS float* fin = (MX_LAS float*)(lds + 8 * TILE);
    const int total = ntb * ncu; int u = first;
    if (u < 0 || u >= total) return;
    u32x4 RA[12], RB[12];
    const int lrow = lane >> 3, lc = lane & 7;
#define SK_LOAD(uu) do { const int tb_ = tb0 + (uu) % ntb, cu_ = (uu) / ntb; int r0_, r1_; E.wrows(cu_, r0_, r1_); \
        const bf16_t* px_ = X + (size_t)(tb_ * 32 + lrow) * K + wave * 128 + lc * 8; const bf16_t* p0_ = Wt + (size_t)(r0_ + lrow) * K + wave * 128 + lc * 8; const bf16_t* p1_ = Wt + (size_t)(r1_ + lrow) * K + wave * 128 + lc * 8; \
        _Pragma("unroll") for (int j_ = 0; j_ < 4; ++j_) { RA[j_] = *(const u32x4*)(px_ + (size_t)j_ * 8 * K); RA[4 + j_] = *(const u32x4*)(p0_ + (size_t)j_ * 8 * K); RA[8 + j_] = *(const u32x4*)(p1_ + (size_t)j_ * 8 * K); \
                                                            RB[j_] = *(const u32x4*)(px_ + (size_t)j_ * 8 * K + 64); RB[4 + j_] = *(const u32x4*)(p0_ + (size_t)j_ * 8 * K + 64); RB[8 + j_] = *(const u32x4*)(p1_ + (size_t)j_ * 8 * K + 64); } } while (0)
#define SK_STAGE(R) do { _Pragma("unroll") for (int j_ = 0; j_ < 12; ++j_) { const int row_ = 8 * j_ + lrow; *(MX_LAS u32x4*)(tile + row_ * 128 + ((lc ^ ((row_ >> 1) & 7)) * 16)) = R[j_]; } } while (0)
#define SK_MMA() do { _Pragma("unroll") for (int s_ = 0; s_ < 4; ++s_) { const int sl_ = ((2 * s_ + hi) ^ ((r32 >> 1) & 7)) * 16; \
        const bf16x8 xf_ = *(const MX_LAS bf16x8*)(tile + r32 * 128 + sl_), f0_ = *(const MX_LAS bf16x8*)(tile + (32 + r32) * 128 + sl_), f1_ = *(const MX_LAS bf16x8*)(tile + (64 + r32) * 128 + sl_); \
        a0 = __builtin_amdgcn_mfma_f32_32x32x16_bf16(f0_, xf_, a0, 0, 0, 0); a1 = __builtin_amdgcn_mfma_f32_32x32x16_bf16(f1_, xf_, a1, 0, 0, 0); } } while (0)
    SK_LOAD(u);
    for (;;) {
        const int tb = tb0 + u % ntb, cu = u / ntb;
        typename Epi::Pre pre = {}; if (wave == 0) pre = E.pre(tb, cu, r32, hi);
        f32x16 a0, a1;
#pragma unroll
        for (int r = 0; r < 16; ++r) { a0[r] = 0.f; a1[r] = 0.f; }
        SK_STAGE(RA); SK_MMA();
        asm volatile("" ::: "memory");
        SK_STAGE(RB); SK_MMA();
        const int un = u + stride; const bool more = un < total;
        Epi::pin(pre);
        if (more) SK_LOAD(un);
        { MX_LAS float* red = (MX_LAS float*)tile;
#pragma unroll
          for (int r = 0; r < 16; ++r) { red[r * 64 + lane] = a0[r]; red[(16 + r) * 64 + lane] = a1[r]; } }
        __syncthreads();
        {
#pragma unroll
            for (int j = 0; j < 4; ++j) { const int reg = 4 * wave + j; float s0 = 0.f;
#pragma unroll
                for (int w = 0; w < 8; ++w) s0 += ((const MX_LAS float*)(lds + w * TILE))[reg * 64 + lane];
                fin[reg * 64 + lane] = s0; }
        }
        __syncthreads();
        if (wave == 0) {
#pragma unroll
            for (int r = 0; r < 16; ++r) { a0[r] = fin[r * 64 + lane]; a1[r] = fin[(16 + r) * 64 + lane]; }
            E(a0, a1, tb, cu, r32, hi, pre);
        }
        __syncthreads();
        if (!more) break;
        u = un;
    }
#undef SK_LOAD
#undef SK_STAGE
#undef SK_MMA
}
template <class Epi> __device__ __forceinline__ void skinny_phase_k2816(MX_LAS unsigned char* lds, const bf16_t* X, const bf16_t* Wt, int ncu, const Epi& E, int ntb, int tb0, int first, int stride) {
    int tid = threadIdx.x; asm volatile("" : "+v"(tid));
    const int wave = __builtin_amdgcn_readfirstlane(tid >> 6), lane = tid & 63, r32 = lane & 31, hi = lane >> 5;
    constexpr int K = 2816, TILE = 96 * 128;
    MX_LAS unsigned char* tile = lds + wave * TILE;
    MX_LAS float* fin = (MX_LAS float*)(lds + 8 * TILE);
    const int nch = wave < 4 ? 6 : 5, c0 = wave < 4 ? 6 * wave : 24 + 5 * (wave - 4);
    const int lrow = lane >> 3, lc = lane & 7;
    if (first < 0) return;
    for (int u = first; u < ntb * ncu; u += stride) {
        const int tb = tb0 + u % ntb, cu = u / ntb; int wr0, wr1; E.wrows(cu, wr0, wr1);
        const bf16_t* px = X + (size_t)(tb * 32 + lrow) * K + lc * 8; const bf16_t* p0 = Wt + (size_t)(wr0 + lrow) * K + lc * 8; const bf16_t* p1 = Wt + (size_t)(wr1 + lrow) * K + lc * 8;
        u32x4 RA[12], RB[12];
#define SK_LOADC(R, ci) do { const int co_ = 64 * (c0 + ((ci) < nch ? (ci) : nch - 1)); \
        _Pragma("unroll") for (int j_ = 0; j_ < 4; ++j_) { R[j_] = *(const u32x4*)(px + (size_t)j_ * 8 * K + co_); R[4 + j_] = *(const u32x4*)(p0 + (size_t)j_ * 8 * K + co_); R[8 + j_] = *(const u32x4*)(p1 + (size_t)j_ * 8 * K + co_); } } while (0)
#define SK_STAGE(R) do { _Pragma("unroll") for (int j_ = 0; j_ < 12; ++j_) { const int row_ = 8 * j_ + lrow; *(MX_LAS u32x4*)(tile + row_ * 128 + ((lc ^ ((row_ >> 1) & 7)) * 16)) = R[j_]; } } while (0)
#define SK_MMA() do { _Pragma("unroll") for (int s_ = 0; s_ < 4; ++s_) { const int sl_ = ((2 * s_ + hi) ^ ((r32 >> 1) & 7)) * 16; \
        const bf16x8 xf_ = *(const MX_LAS bf16x8*)(tile + r32 * 128 + sl_), f0_ = *(const MX_LAS bf16x8*)(tile + (32 + r32) * 128 + sl_), f1_ = *(const MX_LAS bf16x8*)(tile + (64 + r32) * 128 + sl_); \
        a0 = __builtin_amdgcn_mfma_f32_32x32x16_bf16(f0_, xf_, a0, 0, 0, 0); a1 = __builtin_amdgcn_mfma_f32_32x32x16_bf16(f1_, xf_, a1, 0, 0, 0); } } while (0)
        SK_LOADC(RA, 0); SK_LOADC(RB, 1);
        typename Epi::Pre pre = {}; if (wave == 0) pre = E.pre(tb, cu, r32, hi);
        f32x16 a0, a1;
#pragma unroll
        for (int r = 0; r < 16; ++r) { a0[r] = 0.f; a1[r] = 0.f; }
#pragma unroll
        for (int i = 0; i < 6; i += 2) {
            SK_STAGE(RA); SK_MMA(); asm volatile("" ::: "memory");
            if (i + 2 < 6) SK_LOADC(RA, i + 2);
            if (i + 1 < nch) { SK_STAGE(RB); SK_MMA(); } asm volatile("" ::: "memory");
            if (i + 3 < 6) SK_LOADC(RB, i + 3);
        }
        { MX_LAS float* red = (MX_LAS float*)tile;
#pragma unroll
          for (int r = 0; r < 16; ++r) { red[r * 64 + lane] = a0[r]; red[(16 + r) * 64 + lane] = a1[r]; } }
        __syncthreads();
        {
#pragma unroll
            for (int j = 0; j < 4; ++j) { const int reg = 4 * wave + j; float s0 = 0.f;
#pragma unroll
                for (int w = 0; w < 8; ++w) s0 += ((const MX_LAS float*)(lds + w * TILE))[reg * 64 + lane];
                fin[reg * 64 + lane] = s0; }
        }
        __syncthreads();
        if (wave == 0) {
#pragma unroll
            for (int r = 0; r < 16; ++r) { a0[r] = fin[r * 64 + lane]; a1[r] = fin[(16 + r) * 64 + lane]; }
            E(a0, a1, tb, cu, r32, hi, pre);
        }
        __syncthreads();
#undef SK_LOADC
#undef SK_STAGE
#undef SK_MMA
    }
}
#undef SK_GROUP
}
constexpr int NWAVES = 8;
constexpr int D = 1024, MP = 32768, MS = 256, MTOT = MP + MS, DFF = 2816, NMEMROWS = 2048;
constexpr float QSCALE = 0.125f * 1.4426950408889634f;
constexpr float EPS = 1e-6f;
constexpr size_t O_YP = 0, O_YS = 33554432, O_KP = 33816576, O_VP = 58982400, O_KS = 84148224, O_VS = 84344832, O_MK = 84541440, O_MV = 85590016, O_SV = 86638592, O_END = 86835200;
constexpr size_t MiB = 1u << 20;
constexpr size_t WS_CTL = 0, CTL_ZERO_BYTES = 65536;
constexpr size_t WS_WINA = 1 * MiB;
constexpr size_t WS_WINB = 6 * MiB;
constexpr size_t WS_WMKV = 10 * MiB;
constexpr size_t WS_WOUT = 12 * MiB;
constexpr size_t WS_WGU = 16 * MiB;
constexpr size_t WS_WDN = 38 * MiB;
constexpr size_t WS_WSP = 49 * MiB;
constexpr size_t WS_RSM = 50 * MiB;
constexpr size_t WS_SS = 51 * MiB;
constexpr size_t WS_SSV = 54 * MiB;
constexpr size_t WS_MB = 56 * MiB;
constexpr size_t WS_MK = 60 * MiB;
constexpr size_t WS_MV = 66 * MiB;
constexpr size_t WS_XB = 72 * MiB;
constexpr size_t WS_Q = 137 * MiB;
constexpr size_t WS_K = 186 * MiB;
constexpr size_t WS_V = 235 * MiB;
constexpr size_t WS_QM = 284 * MiB;
constexpr size_t WS_OM = 301 * MiB;
constexpr size_t WS_H = 366 * MiB;
constexpr size_t WS_END = 544 * MiB;
static_assert(WS_WINA + 2560ull * 1024 * 2 <= WS_WINB && WS_WINB + 1792ull * 1024 * 2 <= WS_WMKV && WS_WMKV + 1024ull * 1024 * 2 <= WS_WOUT && WS_WOUT + 2ull * 1024 * 1024 * 2 <= WS_WGU &&
              WS_WGU + 2ull * 5632 * 1024 * 2 <= WS_WDN && WS_WDN + 2ull * 1024 * 2816 * 2 <= WS_WSP && WS_WSP + 12ull * 128 * 128 * 2 <= WS_RSM && WS_SS + (size_t)MTOT * 64 <= WS_SSV &&
              WS_SSV + (size_t)MTOT * 48 <= WS_MB && WS_MB + 2048ull * 1024 * 2 <= WS_MK && WS_MK + 2ull * 24 * 65536 * 2 <= WS_MV && WS_MV + 2ull * 24 * 65536 * 2 <= WS_XB &&
              WS_XB + (size_t)MTOT * 1024 * 2 <= WS_Q && WS_Q + (size_t)MTOT * 768 * 2 <= WS_K && WS_K + (size_t)MTOT * 768 * 2 <= WS_V && WS_V + (size_t)MTOT * 768 * 2 <= WS_QM &&
              WS_V - WS_K == WS_K - WS_Q && WS_QM + (size_t)MTOT * 256 * 2 <= WS_OM && WS_OM + (size_t)MTOT * 1024 * 2 <= WS_H && WS_H + (size_t)MTOT * 2816 * 2 <= WS_END, "d_ws map");
constexpr int CW_BAR = 4096;
static_assert((CW_BAR + 3456) * 4 <= (int)CTL_ZERO_BYTES, "barrier words inside the memset region");
constexpr int RING_OFF = 0, RING_BYTES = 131072;
constexpr int LDSCTL_OFF = RING_BYTES, MISC_OFF = LDSCTL_OFF + 320;
constexpr int RC_OFF = RING_BYTES + 1024, RC_STRIDE = 528;
constexpr int LDS_BYTES = 147456;
static_assert(MISC_OFF + 128 <= RC_OFF && RC_OFF + 8 * RC_STRIDE <= LDS_BYTES, "LDS map");

#define GAS __attribute__((address_space(1)))
#define LAS __attribute__((address_space(3)))
typedef unsigned short bf16;
typedef unsigned v4u __attribute__((ext_vector_type(4)));
typedef float f32x4 __attribute__((ext_vector_type(4)));
#define RLX_AGENT __ATOMIC_RELAXED, __HIP_MEMORY_SCOPE_AGENT
#define LDS_WAIT() asm volatile("s_waitcnt lgkmcnt(0)" ::: "memory")
__device__ __forceinline__ unsigned pk2(float lo, float hi) { return mx::cvtpk(lo, hi); }
__device__ __forceinline__ float wave_sum(float v) {
#pragma unroll
    for (int o = 1; o < 64; o <<= 1) v += __shfl_xor(v, o);
    return v;
}

#define XB_TMO      128
#define XB_XCNT(j)  (256  + 64 * (j))
#define XB_XSUB(j)  (1280 + 64 * (j))
#define XB_XGEN(j)  (2304 + 64 * (j))
#define XB_TOP      3328
#define XB_TOPGEN   3392
#define XCD_BAR_WORDS 3456
#define XB_SPIN_CAP (1u << 18)

__device__ __forceinline__ unsigned xb_ld(unsigned* p)              { return __hip_atomic_load(p, __ATOMIC_RELAXED, __HIP_MEMORY_SCOPE_AGENT); }
__device__ __forceinline__ unsigned xb_add(unsigned* p, unsigned v) { return __hip_atomic_fetch_add(p, v, __ATOMIC_RELAXED, __HIP_MEMORY_SCOPE_AGENT); }
__device__ __forceinline__ unsigned xb_xcc_id() { return (unsigned)__builtin_amdgcn_s_getreg((3 << 11) | 20) & 0xFu; }
#define XB_SPIN(cond, bar) do { unsigned _sp = 0; while (cond) { __builtin_amdgcn_s_sleep(1); \
    if ((++_sp & 255u) == 0u) { if (xb_ld(&(bar)[XB_TMO])) break; if (_sp > XB_SPIN_CAP) { atomicAdd(&(bar)[XB_TMO], 1u); break; } } } } while (0)

struct XcdBarrier {
    unsigned* bar; unsigned x;
    volatile LAS unsigned* st;
};

__device__ __forceinline__ XcdBarrier xcd_barrier_post(unsigned* bar, volatile LAS unsigned* st) {
    XcdBarrier b; b.bar = bar; b.x = xb_xcc_id(); b.st = st;
    if (threadIdx.x == 0) st[2] = xb_add(&bar[XB_XCNT(b.x)], 1u);
    return b;
}
__device__ __forceinline__ void xcd_barrier_complete(unsigned* bar, unsigned x, unsigned& nloc, unsigned& nx) {
    const unsigned G = gridDim.x * gridDim.y * gridDim.z;
    unsigned sum, cnt, mine, sp = 0u;
    for (;;) {
        sum = 0u; cnt = 0u; mine = 0u;
#pragma unroll
        for (unsigned j = 0; j < 16; ++j) { const unsigned c = xb_ld(&bar[XB_XCNT(j)]); sum += c; cnt += (c > 0u) ? 1u : 0u; mine = (j == x) ? c : mine; }
        if (sum == G) break;
        __builtin_amdgcn_s_sleep(1);
        if ((++sp & 255u) == 0u) { if (xb_ld(&bar[XB_TMO])) break; if (sp > XB_SPIN_CAP) { atomicAdd(&bar[XB_TMO], 1u); break; } }
    }
    nloc = mine > 0u ? mine : 1u; nx = cnt > 0u ? cnt : 1u;
}

__device__ __forceinline__ void xcd_barrier(const XcdBarrier& b) {
    asm volatile("s_waitcnt vmcnt(0)" ::: "memory");
    __syncthreads();
    if (threadIdx.x == 0) {
        unsigned* bar = b.bar; asm volatile("" : "+s"(bar)); unsigned bx = b.x; asm volatile("" : "+s"(bx));
        __builtin_amdgcn_s_waitcnt(0);
        unsigned nloc = b.st[0], nx = b.st[1];
        if (nloc == 0u) { xcd_barrier_complete(bar, bx, nloc, nx); b.st[0] = nloc; b.st[1] = nx; }
        const unsigned old = xb_add(&bar[XB_XSUB(bx)], 1u);
        const unsigned gen = old / nloc;
        if (old + 1u == (gen + 1u) * nloc) {
            __builtin_amdgcn_fence(__ATOMIC_RELEASE, "agent");
            asm volatile("s_waitcnt vmcnt(0)" ::: "memory");
            const unsigned og = xb_add(&bar[XB_TOP], 1u);
            const unsigned tg = og / nx;
            if (og + 1u == (tg + 1u) * nx) xb_add(&bar[XB_TOPGEN], 1u);
            else XB_SPIN(xb_ld(&bar[XB_TOPGEN]) == tg, bar);
            __builtin_amdgcn_fence(__ATOMIC_ACQUIRE, "agent");
            xb_add(&bar[XB_XGEN(bx)], 1u);
            asm volatile("s_waitcnt vmcnt(0)" ::: "memory");
        } else {
            XB_SPIN(xb_ld(&bar[XB_XGEN(bx)]) == gen, bar);
            __builtin_amdgcn_fence(__ATOMIC_ACQUIRE, "agent");
            asm volatile("s_waitcnt vmcnt(0)" ::: "memory");
        }
    }
    __syncthreads();
}

constexpr bool MK_FORCE_GLOBAL_GROUPS = false;
__device__ __forceinline__ void xcd_group_setup(const XcdBarrier& b) {
    if (threadIdx.x == 0) {
        unsigned* bar = b.bar; const unsigned G = gridDim.x, x = b.x; unsigned cnt = 0u, ord = 0u, ok = (G % 8u == 0u) ? 1u : 0u;
#pragma unroll
        for (unsigned j = 0; j < 16; ++j) { const unsigned c = xb_ld(&bar[XB_XCNT(j)]); if (c) { ++cnt; ord += (j < x) ? 1u : 0u; if (c * 8u != G) ok = 0u; } }
        const bool local = !MK_FORCE_GLOBAL_GROUPS && ok && cnt == 8u;
        b.st[3] = local ? 1u : 0u;
        if (local) { b.st[4] = ord; b.st[5] = b.st[2]; b.st[6] = G / 8u; b.st[7] = 1u; }
        else if (G % 8u == 0u) { b.st[4] = blockIdx.x % 8u; b.st[5] = blockIdx.x / 8u; b.st[6] = G / 8u; b.st[7] = 1u; }
        else { b.st[4] = 0u; b.st[5] = blockIdx.x; b.st[6] = G; b.st[7] = 8u; }
    }
    __syncthreads();
}
__device__ __forceinline__ void grp_barrier(const XcdBarrier& b) {
    if (b.st[3] == 0u) { xcd_barrier(b); return; }
    asm volatile("s_waitcnt vmcnt(0)" ::: "memory");
    __syncthreads();
    if (threadIdx.x == 0) {
        unsigned* bar = b.bar; asm volatile("" : "+s"(bar)); unsigned bx = b.x; asm volatile("" : "+s"(bx));
        __builtin_amdgcn_s_waitcnt(0);
        const unsigned nloc = b.st[0];
        const unsigned old = xb_add(&bar[XB_XSUB(bx)], 1u);
        const unsigned gen = old / nloc;
        if (old + 1u == (gen + 1u) * nloc) xb_add(&bar[XB_XGEN(bx)], 1u);
        else XB_SPIN(xb_ld(&bar[XB_XGEN(bx)]) == gen, bar);
        __builtin_amdgcn_fence(__ATOMIC_ACQUIRE, "agent");
        asm volatile("s_waitcnt vmcnt(0)" ::: "memory");
    }
    __syncthreads();
}


struct Params {
    const float *xp, *xs, *csk, *csv, *cmk, *cmv, *memp, *g_mix, *w_in_a, *w_in_b, *w_sp, *b_sp, *g_sgu, *g_mem, *w_mem_kv, *w_out, *g_ffn, *w_gate, *w_up, *w_down, *g_final;
    float* out; unsigned char* ws;
};

template <int MODE> __device__ __forceinline__ void tr_item(const float* W, int K, int N, bf16* WT, const float* g, LAS float* scr, int item, int lane) {
    const int nblk = N / 32, kb = item / nblk, nb = item % nblk, k0 = 64 * kb, n0 = 32 * nb;
    f32x4 v[8]; float gk[8];
#pragma unroll
    for (int i = 0; i < 8; ++i) { const int kk = (lane >> 3) + 8 * i; v[i] = *(const GAS f32x4*)(W + (size_t)(k0 + kk) * N + n0 + (lane & 7) * 4); gk[i] = g ? g[k0 + kk] : 1.f; }
#pragma unroll
    for (int i = 0; i < 8; ++i) { const int kk = (lane >> 3) + 8 * i; LAS float* d = scr + kk * 33 + (lane & 7) * 4; const f32x4 w = v[i] * gk[i]; d[0] = w[0]; d[1] = w[1]; d[2] = w[2]; d[3] = w[3]; }
    LDS_WAIT(); asm volatile("" ::: "memory");
    float sc = 1.f; int dr = n0;
    if (MODE == 1) sc = (n0 < 768 || n0 >= 2304) ? QSCALE : 1.f;
    if (MODE == 2) sc = (n0 >= 1536) ? QSCALE : 1.f;
    if (MODE == 3) dr = 256 * (n0 >> 7) + (n0 & 127);
    if (MODE == 4) dr = 256 * (n0 >> 7) + 128 + (n0 & 127);
    const int c = lane & 7;
#pragma unroll
    for (int j = 0; j < 4; ++j) { const int n = (lane >> 3) + 8 * j; const LAS float* s = scr + (8 * c) * 33 + n;
        v4u o; o.x = pk2(s[0 * 33] * sc, s[1 * 33] * sc); o.y = pk2(s[2 * 33] * sc, s[3 * 33] * sc); o.z = pk2(s[4 * 33] * sc, s[5 * 33] * sc); o.w = pk2(s[6 * 33] * sc, s[7 * 33] * sc);
        *(GAS v4u*)(WT + (size_t)(dr + n) * K + k0 + 8 * c) = o; }
    LDS_WAIT(); asm volatile("" ::: "memory");
}
__device__ __forceinline__ float row_to_bf16(const float* xrow, bf16* orow, int lane) {
    const GAS f32x4* xr = (const GAS f32x4*)xrow + lane; f32x4 v[4]; float s = 0.f;
#pragma unroll
    for (int j = 0; j < 4; ++j) { v[j] = xr[64 * j]; s += (v[j].x * v[j].x + v[j].y * v[j].y) + (v[j].z * v[j].z + v[j].w * v[j].w); }
    GAS unsigned long long* o8 = (GAS unsigned long long*)orow + lane;
#pragma unroll
    for (int j = 0; j < 4; ++j) o8[64 * j] = (unsigned long long)pk2(v[j].x, v[j].y) | ((unsigned long long)pk2(v[j].z, v[j].w) << 32);
    return wave_sum(s);
}

typedef const Params __attribute__((address_space(4))) CParams;
#define ENV() CParams* q = (CParams*)__builtin_amdgcn_kernarg_segment_ptr(); asm volatile("" : "+s"(q)); unsigned char* const ws = q->ws; (void)ws; \
    int tid_ = threadIdx.x; asm volatile("" : "+v"(tid_)); const int tid = tid_, lane = tid & 63, wave = __builtin_amdgcn_readfirstlane(tid >> 6); const int G = gridDim.x, gw = blockIdx.x * NWAVES + wave, NGW = G * NWAVES; \
    (void)lane; (void)gw; (void)NGW; const int vcu = (G % 8 == 0) ? (int)(blockIdx.x % 8) * (G / 8) + (int)(blockIdx.x / 8) : (int)blockIdx.x; (void)vcu; LAS unsigned char* const lds = (LAS unsigned char*)lds_raw; LAS float* const rcs = (LAS float*)(lds + RC_OFF + wave * RC_STRIDE); (void)rcs; LAS unsigned char* const wslot = lds + RING_OFF + wave * mx::WAVE_LDS; (void)wslot
#define WSB(off) ((bf16*)(ws + (off)))
#define WSF(off) ((float*)(ws + (off)))
__global__ void __launch_bounds__(NWAVES * 64, 2) mk_fwd(Params Pdummy) {
    extern __shared__ __attribute__((aligned(16))) unsigned char lds_raw[];
    XcdBarrier bar;
    { ENV();
      for (int u = tid; u < (LDS_BYTES - LDSCTL_OFF) / 4; u += NWAVES * 64) ((LAS unsigned*)(lds + LDSCTL_OFF))[u] = 0u;
      __syncthreads();
      bar = xcd_barrier_post((unsigned*)(ws + WS_CTL) + CW_BAR, (volatile LAS unsigned*)(lds + MISC_OFF) + 8); }

    { ENV();
        bf16* WINA = WSB(WS_WINA); bf16* WINB = WSB(WS_WINB); bf16* WMKV = WSB(WS_WMKV); bf16* WOUT = WSB(WS_WOUT); bf16* WGU = WSB(WS_WGU); bf16* WDN = WSB(WS_WDN);
        LAS float* scr = (LAS float*)(lds + RING_OFF + wave * 16384);
        constexpr int I_A = 16 * 80, I_B = 16 * 56, I_M = 16 * 16, I_O = 16 * 32, I_G = 16 * 88, I_D = 44 * 32;
        constexpr int NITEMS = I_A + I_B + 2 * I_M + 2 * I_O + 4 * I_G + 2 * I_D;
        for (int it = gw; it < NITEMS; it += NGW) {
            int r = it;
            if (r < I_A) { tr_item<1>(q->w_in_a, 1024, 2560, WINA, q->g_mix, scr, r, lane); continue; } r -= I_A;
            if (r < I_B) { tr_item<2>(q->w_in_b, 1024, 1792, WINB, q->g_mix + 1024, scr, r, lane); continue; } r -= I_B;
            if (r < 2 * I_M) { const int l = r / I_M; tr_item<0>(q->w_mem_kv + (size_t)l * 1024 * 512, 1024, 512, WMKV + (size_t)l * 512 * 1024, q->g_mem + l * 1024, scr, r - l * I_M, lane); continue; } r -= 2 * I_M;
            if (r < 2 * I_O) { const int l = r / I_O; tr_item<0>(q->w_out + (size_t)l * 1024 * 1024, 1024, 1024, WOUT + (size_t)l * 1024 * 1024, nullptr, scr, r - l * I_O, lane); continue; } r -= 2 * I_O;
            if (r < 2 * I_G) { const int l = r / I_G; tr_item<3>(q->w_gate + (size_t)l * 1024 * DFF, 1024, DFF, WGU + (size_t)l * 5632 * 1024, q->g_ffn + l * 1024, scr, r - l * I_G, lane); continue; } r -= 2 * I_G;
            if (r < 2 * I_G) { const int l = r / I_G; tr_item<4>(q->w_up + (size_t)l * 1024 * DFF, 1024, DFF, WGU + (size_t)l * 5632 * 1024, q->g_ffn + l * 1024, scr, r - l * I_G, lane); continue; } r -= 2 * I_G;
            { const int l = r / I_D; tr_item<0>(q->w_down + (size_t)l * DFF * 1024, DFF, 1024, WDN + (size_t)l * 1024 * DFF, nullptr, scr, r - l * I_D, lane); }
        }
        { bf16* XB = WSB(WS_XB); float* SS = WSF(WS_SS); const float* xp = q->xp; const float* xs = q->xs;
          for (int m = 4 * gw; m < MTOT; m += 4 * NGW) {
            const float* x0 = m < MP ? xp + (size_t)m * D : xs + (size_t)(m - MP) * D;
            f32x4 v[4][4]; float s[4];
#pragma unroll
            for (int k = 0; k < 4; ++k) { const GAS f32x4* r = (const GAS f32x4*)(x0 + (size_t)k * D) + lane;
#pragma unroll
                for (int j = 0; j < 4; ++j) v[k][j] = r[64 * j]; }
#pragma unroll
            for (int k = 0; k < 4; ++k) { float t = 0.f;
#pragma unroll
                for (int j = 0; j < 4; ++j) t += (v[k][j].x * v[k][j].x + v[k][j].y * v[k][j].y) + (v[k][j].z * v[k][j].z + v[k][j].w * v[k][j].w);
                GAS unsigned long long* o = (GAS unsigned long long*)(XB + (size_t)(m + k) * D) + lane;
#pragma unroll
                for (int j = 0; j < 4; ++j) o[64 * j] = (unsigned long long)pk2(v[k][j].x, v[k][j].y) | ((unsigned long long)pk2(v[k][j].z, v[k][j].w) << 32);
                s[k] = wave_sum(t); }
            { const int k = lane >> 4; const float sk = k == 0 ? s[0] : k == 1 ? s[1] : k == 2 ? s[2] : s[3]; SS[(size_t)m * 16 + lane] = (lane & 15) == 0 ? sk : 0.f; } } }
        { bf16* MB = WSB(WS_MB); float* RSM = WSF(WS_RSM); const float* memp = q->memp;
          for (int m = gw; m < NMEMROWS; m += NGW) { const float s = row_to_bf16(memp + (size_t)m * D, MB + (size_t)m * D, lane); if (lane == 0) RSM[m] = __builtin_amdgcn_rsqf(s * (1.0f / 1024.0f) + EPS); } }
        { const float* cmk = q->cmk; const float* cmv = q->cmv; bf16* MKB = WSB(WS_MK); bf16* MVB = WSB(WS_MV);
          for (int it = blockIdx.x * 512 + tid; it < 2 * 262144; it += G * 512) { const int which = it / 262144, e = it % 262144, l = e / 131072, rem = e % 131072;
            const float* src = (which ? cmv : cmk) + (size_t)l * 1048576 + (size_t)rem * 8; bf16* dst = (which ? MVB : MKB) + (size_t)l * 24 * 65536 + 8 * 65536 + (size_t)rem * 8;
            const f32x4 a = *(const f32x4*)src, b = *(const f32x4*)(src + 4); *(v4u*)dst = mx::pk8(a, b); } }
        { const float* wsp = q->w_sp; bf16* WSPB = WSB(WS_WSP);
          for (int it = blockIdx.x * 512 + tid; it < 24576; it += G * 512) { const int t = (it % 2048) / 16, s0 = (it % 16) * 8; const float* src = wsp + (size_t)it * 8;
            f32x4 a = *(const f32x4*)src, b = *(const f32x4*)(src + 4);
#pragma unroll
            for (int e = 0; e < 4; ++e) { if (s0 + e > t) a[e] = 0.f; if (s0 + 4 + e > t) b[e] = 0.f; }
            *(v4u*)(WSPB + (size_t)it * 8) = mx::pk8(a, b); } }
    }
    xcd_barrier(bar);
    xcd_group_setup(bar);
#define GENV() volatile LAS unsigned* gst_ = (volatile LAS unsigned*)(lds + MISC_OFF) + 8; const int grp = __builtin_amdgcn_readfirstlane((int)gst_[4]), rank = __builtin_amdgcn_readfirstlane((int)gst_[5]), \
    GS = __builtin_amdgcn_readfirstlane((int)gst_[6]), nb = __builtin_amdgcn_readfirstlane((int)gst_[7]); (void)grp; (void)rank; (void)GS; (void)nb

    { ENV(); GENV();
        const bool early = false;
#define P1_SMALL() do { { sk::SkMemKV E{WSF(WS_RSM), WSB(WS_MK), WSB(WS_MV), q->out + O_MK, q->out + O_MV, 0}; sk::skinny_phase_k1024(lds + RING_OFF, WSB(WS_MB), WSB(WS_WMKV), 8, E, 8 * nb, 8 * nb * grp, rank, GS); } \
          { sk::SkInA E{WSF(WS_SS), WSB(WS_Q), WSB(WS_QM), (WS_K - WS_Q) / 2, q->out + O_KS, q->out + O_VS}; sk::skinny_phase_k1024(lds + RING_OFF, WSB(WS_XB) + (size_t)MP * D, WSB(WS_WINA), 40, E, nb, nb * grp, rank, GS); } } while (0)
        if (early) { P1_SMALL(); __syncthreads(); }
        { pg8::Gemm g{WSB(WS_XB), WSB(WS_WINA), MP, 2560, 1024}; pg8::LocalOrder S; S.init(16 * nb * grp, 16 * nb, 2560, GS, rank, (grp & 1) ? 5 : 0);
          rcs[128] = __int_as_float(-1); pg8::EpiInA E{pg8::RstdCache{rcs, WSF(WS_SS)}, WSB(WS_Q), WSB(WS_QM), (WS_K - WS_Q) / 2, q->out + O_KP, q->out + O_VP};
          pg8::gemm_phase<pg8::EpiInA, pg8::LocalOrder, true, true>(lds + RING_OFF, g, S, E); }
        __syncthreads();
        if (!early) P1_SMALL();
#undef P1_SMALL
    }
    grp_barrier(bar);

    for (int l = 0; l < 2; ++l) {
        if (l == 0) { ENV(); GENV();
            const mx::SbArgs SA{WSB(WS_Q), WSB(WS_K), WSB(WS_V), q->csk, q->csv, WSB(WS_OM)};
            for (int r = rank * NWAVES + wave; r < 24 * nb; r += GS * NWAVES) mx::sb_sample_unit(SA, wslot, 2 * nb * grp + r / 12, r % 12, lane);
            __syncthreads();
            { const int tot = 192 * nb, per = (tot + GS - 1) / GS, k0 = rank * per, k1 = k0 + per < tot ? k0 + per : tot; mx::sb_wg_units(SA, lds + RING_OFF, tot * grp + k0, tot * grp + k1, tid); }
        } else { ENV(); GENV();
            const int lgnb = nb == 1 ? 0 : 3;
            const mx::SgArgs GA{WSB(WS_Q), WSB(WS_K), WSB(WS_WSP), WSF(WS_SSV), q->g_sgu, q->b_sp, WSB(WS_OM), q->out + O_SV, 5 + lgnb, 32 * nb * grp, 1 + lgnb, 2 * nb * grp};
            { const int tot = 384 * nb, per = (tot + GS - 1) / GS, k0 = rank * per, k1 = k0 + per < tot ? k0 + per : tot; mx::sg_wg_units(GA, lds + RING_OFF, k0, k1, false, tid); }
            for (int u = rank; u < 24 * nb; u += GS) mx::sg_wg_units(GA, lds + RING_OFF, u, u + 1, true, tid);
        }
        __syncthreads();
        { ENV(); GENV();
            const mx::MaArgs MA{WSB(WS_QM), WSB(WS_MK) + (size_t)l * 24 * 65536, WSB(WS_MV) + (size_t)l * 24 * 65536, WSB(WS_OM)};
            for (int k = rank; k < 32 * nb; k += GS) { const int u = 32 * nb * grp + k, bm = u >> 3, b = bm >> 2; mx::ma_wg_unit(MA, lds + RING_OFF, (size_t)b * 4096 + (u & 7) * 512, b, bm & 3, 16, 32, tid); }
            { const int nsm = 8 * nb;
              for (int k = (GS >= nsm ? rank - (GS - nsm) : rank); k < nsm; k += GS) if (k >= 0) { const int qq = nsm * grp + k, b = qq >> 2; mx::ma_wg_unit(MA, lds + RING_OFF, (size_t)MP + 16 * b, 8 + b, qq & 3, 1, 16, tid); } }
        }
        grp_barrier(bar);
        { ENV(); GENV(); const bf16* W = WSB(WS_WOUT) + (size_t)l * 1024 * 1024; bf16* XB = WSB(WS_XB);
          const bool early = false;
#define OUT_SMALL() do { sk::SkResidT<false, false> E{XB + (size_t)MP * D, XB + (size_t)MP * D, WSF(WS_SS)}; sk::skinny_phase_k1024(lds + RING_OFF, WSB(WS_OM) + (size_t)MP * D, W, 16, E, nb, nb * grp, rank, GS); } while (0)
          if (early) { OUT_SMALL(); __syncthreads(); }
          { pg8::Gemm g{WSB(WS_OM), W, MP, 1024, 1024}; pg8::LocalOrder S; S.init(16 * nb * grp, 16 * nb, 1024, GS, rank);
            pg8::EpiResidT<false, false> E{XB, XB, WSF(WS_SS)};
            pg8::gemm_phase<pg8::EpiResidT<false, false>, pg8::LocalOrder, true, true>(lds + RING_OFF, g, S, E); }
          __syncthreads();
          if (!early) OUT_SMALL();
#undef OUT_SMALL
        }
        grp_barrier(bar);
        { ENV(); GENV(); const bf16* W = WSB(WS_WGU) + (size_t)l * 5632 * 1024;
          const bool early = false;
#define GU_SMALL() do { sk::SkGateUp E{WSF(WS_SS), WSB(WS_H)}; sk::skinny_phase_k1024(lds + RING_OFF, WSB(WS_XB) + (size_t)MP * D, W, 88, E, nb, nb * grp, rank, GS); } while (0)
          if (early) { GU_SMALL(); __syncthreads(); }
          { pg8::Gemm g{WSB(WS_XB), W, MP, 5632, 1024}; pg8::LocalOrder S; S.init(16 * nb * grp, 16 * nb, 5632, GS, rank);
            rcs[128] = __int_as_float(-1); pg8::EpiGateUp E{pg8::RstdCache{rcs, WSF(WS_SS)}, WSB(WS_H)};
            pg8::gemm_phase<pg8::EpiGateUp, pg8::LocalOrder, true, true>(lds + RING_OFF, g, S, E); }
          __syncthreads();
          if (!early) GU_SMALL();
#undef GU_SMALL
        }
        grp_barrier(bar);
        { ENV(); GENV(); const bf16* W = WSB(WS_WDN) + (size_t)l * 1024 * DFF; bf16* XB = WSB(WS_XB);
          const bool early = false;
#define DN_SMALL() do { sk::SkResidT<false, false> E{XB + (size_t)MP * D, XB + (size_t)MP * D, WSF(WS_SS)}; sk::skinny_phase_k2816(lds + RING_OFF, WSB(WS_H) + (size_t)MP * DFF, W, 16, E, nb, nb * grp, rank, GS); } while (0)
          if (early) { DN_SMALL(); __syncthreads(); }
          { pg8::Gemm g{WSB(WS_H), W, MP, 1024, DFF}; pg8::LocalOrder S; S.init(16 * nb * grp, 16 * nb, 1024, GS, rank);
            pg8::EpiResidT<false, false> E{XB, XB, WSF(WS_SS)};
            pg8::gemm_phase<pg8::EpiResidT<false, false>, pg8::LocalOrder, true, true>(lds + RING_OFF, g, S, E); }
          __syncthreads();
          if (!early) DN_SMALL();
#undef DN_SMALL
        }
        grp_barrier(bar);
        if (l == 0) {
            { ENV(); GENV();
              const int lo = GS / 2;
              { sk::SkInB E{WSF(WS_SS), WSB(WS_Q), WSB(WS_QM), (WS_K - WS_Q) / 2, WSF(WS_SSV)}; sk::skinny_phase_k1024(lds + RING_OFF, WSB(WS_XB) + (size_t)MP * D, WSB(WS_WINB), 28, E, nb, nb * grp, rank - lo, GS - lo); }
              { sk::SkMemKV E{WSF(WS_RSM), WSB(WS_MK), WSB(WS_MV), q->out + O_MK, q->out + O_MV, 1}; sk::skinny_phase_k1024(lds + RING_OFF, WSB(WS_MB), WSB(WS_WMKV), 8, E, 8 * nb, 8 * nb * grp, rank - lo, GS - lo); }
              __syncthreads();
              { pg8::Gemm g{WSB(WS_XB), WSB(WS_WINB), MP, 1792, 1024}; pg8::LocalOrder S; S.init(16 * nb * grp, 16 * nb, 1792, GS, rank);
                rcs[128] = __int_as_float(-1); pg8::EpiInB E{pg8::RstdCache{rcs, WSF(WS_SS)}, WSB(WS_Q), WSB(WS_QM), (WS_K - WS_Q) / 2, WSF(WS_SSV)};
                pg8::gemm_phase<pg8::EpiInB, pg8::LocalOrder, true, true>(lds + RING_OFF, g, S, E); } }
            grp_barrier(bar);
        }
    }
    { ENV(); GENV(); const bf16* XB = WSB(WS_XB); float* O = q->out + O_YP; const float* SS = WSF(WS_SS); const f32x4* gf = (const f32x4*)q->g_final + 2 * lane;
      const int npr = 4096 * nb, ntot = npr + 32 * nb, wstep = GS * NWAVES;
      f32x4 gv[4];
#pragma unroll
      for (int j = 0; j < 2; ++j) { gv[2 * j] = gf[128 * j]; gv[2 * j + 1] = gf[128 * j + 1]; }
      for (int i0 = rank * NWAVES + wave; i0 < ntot; i0 += 4 * wstep) {
        int mrow[4]; float ssv[4]; v4u xr[4][2];
#pragma unroll
        for (int k = 0; k < 4; ++k) { const int i = i0 + k * wstep, ic = i < ntot ? i : i0; mrow[k] = ic < npr ? npr * grp + ic : MP + 32 * nb * grp + (ic - npr);
            ssv[k] = lane < 16 ? SS[(size_t)mrow[k] * 16 + lane] : 0.f;
            const GAS v4u* xp = (const GAS v4u*)(XB + (size_t)mrow[k] * D) + lane; xr[k][0] = xp[0]; xr[k][1] = xp[64]; }
#pragma unroll
        for (int k = 0; k < 4; ++k) { float s = ssv[k];
            s += __shfl_xor(s, 1); s += __shfl_xor(s, 2); s += __shfl_xor(s, 4); s += __shfl_xor(s, 8);
            s = __shfl(s, 0);
            const float rs = __builtin_amdgcn_rsqf(s * (1.0f / 1024.0f) + EPS);
            if (i0 + k * wstep < ntot) { GAS f32x4* orow = (GAS f32x4*)(O + (size_t)mrow[k] * D) + 2 * lane;
#pragma unroll
                for (int j = 0; j < 2; ++j) { const v4u r = xr[k][j];
                    const f32x4 a = {__uint_as_float(r.x << 16), __uint_as_float(r.x & 0xffff0000u), __uint_as_float(r.y << 16), __uint_as_float(r.y & 0xffff0000u)};
                    const f32x4 b = {__uint_as_float(r.z << 16), __uint_as_float(r.z & 0xffff0000u), __uint_as_float(r.w << 16), __uint_as_float(r.w & 0xffff0000u)};
                    orow[128 * j] = a * rs * gv[2 * j]; orow[128 * j + 1] = b * rs * gv[2 * j + 1]; } } }
      } }
}

extern "C" void kernel_launch(void* const* d_in, const int* in_sizes, int n_in, void* d_out, int out_size, void* d_ws, size_t ws_size, hipStream_t stream) {
    static int grid = 0;
    if (grid == 0) {
        if (n_in != 21 || (size_t)out_size != O_END || ws_size < WS_END) { fprintf(stderr, "kernel_launch: unexpected shapes (n_in %d, out %d, ws %zu); nothing launched\n", n_in, out_size, ws_size); grid = -1; return; }
        int dev = 0, cus = 0, per_cu = 0;
        if (hipGetDevice(&dev) != hipSuccess || hipDeviceGetAttribute(&cus, hipDeviceAttributeMultiprocessorCount, dev) != hipSuccess) { grid = -1; return; }
        if (hipFuncSetAttribute((const void*)mk_fwd, hipFuncAttributeMaxDynamicSharedMemorySize, LDS_BYTES) != hipSuccess) { fprintf(stderr, "kernel_launch: hipFuncSetAttribute failed\n"); grid = -1; return; }
        if (hipOccupancyMaxActiveBlocksPerMultiprocessor(&per_cu, (const void*)mk_fwd, NWAVES * 64, LDS_BYTES) != hipSuccess || per_cu < 1) fprintf(stderr, "kernel_launch: occupancy query reports %d\n", per_cu);
        (void)hipGetLastError();
        grid = cus;
    }
    if (grid < 0) return;
    if (hipMemsetAsync((char*)d_ws + WS_CTL, 0, CTL_ZERO_BYTES, stream) != hipSuccess) return;
    Params p{};
    p.xp = (const float*)d_in[0]; p.xs = (const float*)d_in[1]; p.csk = (const float*)d_in[2]; p.csv = (const float*)d_in[3]; p.cmk = (const float*)d_in[4]; p.cmv = (const float*)d_in[5];
    p.memp = (const float*)d_in[6]; p.g_mix = (const float*)d_in[7]; p.w_in_a = (const float*)d_in[8]; p.w_in_b = (const float*)d_in[9]; p.w_sp = (const float*)d_in[10]; p.b_sp = (const float*)d_in[11];
    p.g_sgu = (const float*)d_in[12]; p.g_mem = (const float*)d_in[13]; p.w_mem_kv = (const float*)d_in[14]; p.w_out = (const float*)d_in[15]; p.g_ffn = (const float*)d_in[16];
    p.w_gate = (const float*)d_in[17]; p.w_up = (const float*)d_in[18]; p.w_down = (const float*)d_in[19]; p.g_final = (const float*)d_in[20];
    p.out = (float*)d_out; p.ws = (unsigned char*)d_ws;
    hipLaunchKernelGGL(mk_fwd, dim3(grid), dim3(NWAVES * 64), LDS_BYTES, stream, p);
    const hipError_t le = hipPeekAtLastError();
    if (le != hipSuccess) fprintf(stderr, "kernel_launch: launch failed: %s\n", hipGetErrorName(le));
}
```

```cpp
#include <hip/hip_runtime.h>
#include <hip/hip_bf16.h>
#include <cstdio>
#include <cstdint>
#include <cmath>
namespace pg8 {
#define PG8_LAS __attribute__((address_space(3)))
typedef unsigned short bf16_t;
typedef short bf16x8 __attribute__((ext_vector_type(8)));
typedef float f32x4 __attribute__((ext_vector_type(4)));
typedef unsigned u32x4 __attribute__((ext_vector_type(4)));
constexpr int BM = 256, BK = 64, HALF = 128, HTB = HALF * BK * 2  , STAGE_BYTES = 8 * HTB, NXCD = 8, WGM = 8;

__host__ __device__ __forceinline__ int lds_byte(int r, int c) { const int st = (r >> 4) * 2 + (c >> 5), rr = r & 15, cc = c & 31, ob = rr * 64 + cc * 2; return st * 1024 + (ob ^ (((ob >> 9) & 1) << 5)); }
__host__ __device__ __forceinline__ void stage_rc(int b, int& R, int& C) { const int st = b / 1024, sb = b % 1024, swz = sb ^ (((sb >> 9) & 1) << 5); R = (st >> 1) * 16 + swz / 64; C = (st & 1) * 32 + (swz % 64) / 2; }
__host__ __device__ __forceinline__ int perm32(int rho) { const int n = rho >> 4, i = rho & 15; return 8 * (i >> 2) + 4 * n + (i & 3); }

struct Unit { int pm, pn; };
struct Gemm { const bf16_t* A; const bf16_t* Bt; int M, N, K; };

struct StaticOrder {
    int nM, nN, nwg, G, c;
    __host__ __device__ void init(int M, int N, int G_, int c_) { nM = M / BM; nN = N / BM; nwg = nM * nN; G = G_; c = c_; }
    __host__ __device__ bool next(int i, Unit& u) const {
        const long L = (long)i * G + c; if (L >= nwg) return false;
        int wgid = (int)L; { const int q = nwg / NXCD, r = nwg % NXCD, xcd = wgid % NXCD, off = wgid / NXCD; wgid = (xcd < r ? xcd * (q + 1) : r * (q + 1) + (xcd - r) * q) + off; }
        const int nig = WGM * nN, gid = wgid / nig, fm = gid * WGM, gsz = (nM - fm) < WGM ? (nM - fm) : WGM;
        u.pm = fm + ((wgid % nig) % gsz); u.pn = (wgid % nig) / gsz; return true;
    }
    __device__ __forceinline__ void a_ready(const Unit&) const {}
    __device__ __forceinline__ void done(const Unit&) const {}
};
struct LocalOrder {
    int nM, nN, nwg, GS, r, pm0, rot;
    __host__ __device__ void init(int pm0_, int npanels, int N, int GS_, int r_, int rot_ = 0) { pm0 = pm0_; nM = npanels; nN = N / BM; nwg = nM * nN; GS = GS_; r = r_; rot = rot_; }
    __host__ __device__ bool next(int i, Unit& u) const {
        const int L = i * GS + r; if (L >= nwg) return false;
        const int nig = WGM * nN, gid = L / nig, rem = L - gid * nig;
        int pn = rem / WGM + rot; if (pn >= nN) pn -= nN;
        u.pm = pm0 + gid * WGM + (rem % WGM); u.pn = pn; return true;
    }
    __device__ __forceinline__ void a_ready(const Unit&) const {}
    __device__ __forceinline__ void done(const Unit&) const {}
};

typedef float f32x2 __attribute__((ext_vector_type(2)));
typedef __bf16 bf16x2_t __attribute__((ext_vector_type(2)));
__device__ __forceinline__ unsigned cvt_pk_bf16(float lo, float hi) { const f32x2 v = {lo, hi}; const bf16x2_t b = __builtin_convertvector(v, bf16x2_t); return __builtin_bit_cast(unsigned, b); }
__device__ __forceinline__ f32x2 gelu_pk(f32x2 v) {
    const f32x2 av = __builtin_elementwise_abs(v), d = av * 0.2316418882f + 1.0f;
    f32x2 t; t.x = __builtin_amdgcn_rcpf(d.x); t.y = __builtin_amdgcn_rcpf(d.y);
    f32x2 q = t * 0.5307027145f + (-0.7265760135f); q = q * t + 0.7107068705f; q = q * t + (-0.142248368f); q = q * t + 0.127414796f; q = q * t;
    const f32x2 s = (v * v) * (-0.72134752044f);
    f32x2 e; e.x = __builtin_amdgcn_exp2f(s.x); e.y = __builtin_amdgcn_exp2f(s.y);
    const f32x2 m = v * (q * e), r = v - m;
    f32x2 o; o.x = v.x < 0.f ? m.x : r.x; o.y = v.y < 0.f ? m.y : r.y; return o;
}

typedef float f32x2 __attribute__((ext_vector_type(2)));
constexpr int MP = 32768, MTOT = 33024;
constexpr float RMS_EPS = 1e-6f;
__device__ __forceinline__ u32x4 pack8(const f32x4 v0, const f32x4 v1) { u32x4 w; w.x = cvt_pk_bf16(v0[0], v0[1]); w.y = cvt_pk_bf16(v0[2], v0[3]); w.z = cvt_pk_bf16(v1[0], v1[1]); w.w = cvt_pk_bf16(v1[2], v1[3]); return w; }
template <int NP> __device__ __forceinline__ float row_rstd(const float* ss, int row, float inv_n) {
    const f32x4* p = (const f32x4*)(ss + (size_t)row * NP); float s = 0.f;
#pragma unroll
    for (int i = 0; i < NP / 4; ++i) { const f32x4 v = p[i]; s += (v[0] + v[1]) + (v[2] + v[3]); }
    return __builtin_amdgcn_rsqf(s * inv_n + RMS_EPS);
}
__device__ __forceinline__ float fast_sigmoid(float x) { return __builtin_amdgcn_rcpf(1.0f + __builtin_amdgcn_exp2f(-1.4426950408889634f * x)); }
__device__ __forceinline__ float gelu_tanh(float x) { const float y = 0.7978845608028654f * (x + 0.044715f * x * x * x); return x * fast_sigmoid(2.0f * y); }

struct RstdCache {
    PG8_LAS float* slice; const float* ss;
    __device__ __forceinline__ void prepare(int pm, int wr, int lane) const {
        PG8_LAS int* tag = (PG8_LAS int*)(slice + 128);
        if (__builtin_amdgcn_readfirstlane(*tag) == pm) return;
        f32x4 v[2][4];
#pragma unroll
        for (int k = 0; k < 2; ++k) { const int idx = lane + 64 * k, row = pm * BM + (idx >> 6) * HALF + wr * 64 + (idx & 63); const f32x4* p = (const f32x4*)(ss + (size_t)row * 16);
#pragma unroll
            for (int i = 0; i < 4; ++i) v[k][i] = p[i]; }
#pragma unroll
        for (int k = 0; k < 2; ++k) { float s = 0.f;
#pragma unroll
            for (int i = 0; i < 4; ++i) s += (v[k][i][0] + v[k][i][1]) + (v[k][i][2] + v[k][i][3]);
            slice[lane + 64 * k] = __builtin_amdgcn_rsqf(s * (1.0f / 1024.0f) + RMS_EPS); }
        *tag = pm;
    }
    __device__ __forceinline__ float get(int ai, int m, int fr) const { return slice[ai * 64 + m * 16 + fr]; }
};
struct EpiInA {
    static constexpr bool PERM = true, AFTER_DRAIN = false;
    RstdCache rc; bf16_t *Q, *QM; size_t qkv_stride; float *kout_p, *vout_p;
    __device__ __forceinline__ void operator()(const f32x4 (&acc)[2][2][4][2], const Unit& u, int wr, int wc, int fr, int fq) const {
        const int t = u.pn / 3, colt = (u.pn - 3 * t) * BM + wc * 32 + 8 * fq;
        bf16_t* dst = t == 3 ? QM : Q + (size_t)t * qkv_stride; const int ld = t == 3 ? 256 : 768;
        float* fo = t == 1 ? kout_p : vout_p;
        const bool wf = (t == 1 || t == 2);
        rc.prepare(u.pm, wr, fq * 16 + fr);
#pragma unroll
        for (int ai = 0; ai < 2; ++ai)
#pragma unroll
            for (int m = 0; m < 4; ++m) { const int row = u.pm * BM + ai * HALF + wr * 64 + m * 16 + fr; const float rs = rc.get(ai, m, fr);
#pragma unroll
                for (int bj = 0; bj < 2; ++bj) { const f32x4 v0 = acc[ai][bj][m][0] * rs, v1 = acc[ai][bj][m][1] * rs; const int col = colt + bj * HALF;
                    *(u32x4*)(dst + (size_t)row * ld + col) = pack8(v0, v1);
                    if (wf) {
                        f32x4 A, B;
#pragma unroll
                        for (int c = 0; c < 4; ++c) { const auto s1 = __builtin_amdgcn_permlane16_swap(__float_as_uint(v0[c]), __float_as_uint(v1[c]), false, false);
                            const auto s2 = __builtin_amdgcn_permlane32_swap(s1[0], s1[1], false, false); A[c] = __uint_as_float(s2[0]); B[c] = __uint_as_float(s2[1]); }
                        float* f = fo + (size_t)row * 768 + (col - 8 * fq) + 4 * fq; __builtin_nontemporal_store(A, (f32x4*)f); __builtin_nontemporal_store(B, (f32x4*)(f + 16)); } } }
    }
};
template <bool BASE_F32, bool OUT_F32> struct EpiResidT {
    static constexpr bool PERM = true, AFTER_DRAIN = false;
    const void* base; void* out; float* ss;
    __device__ __forceinline__ void operator()(const f32x4 (&acc)[2][2][4][2], const Unit& u, int wr, int wc, int fr, int fq) const {
        const int col0 = u.pn * BM + wc * 32 + 8 * fq;
#pragma unroll
        for (int ai = 0; ai < 2; ++ai) {
            f32x4 b[4][2][2];
#pragma unroll
            for (int m = 0; m < 4; ++m) { const size_t off = (size_t)(u.pm * BM + ai * HALF + wr * 64 + m * 16 + fr) * 1024 + col0;
#pragma unroll
                for (int bj = 0; bj < 2; ++bj) {
                    if (BASE_F32) { b[m][bj][0] = *(const f32x4*)((const float*)base + off + bj * HALF); b[m][bj][1] = *(const f32x4*)((const float*)base + off + bj * HALF + 4); }
                    else { const u32x4 r = *(const u32x4*)((const bf16_t*)base + off + bj * HALF);
                        b[m][bj][0] = (f32x4){__uint_as_float(r.x << 16), __uint_as_float(r.x & 0xffff0000u), __uint_as_float(r.y << 16), __uint_as_float(r.y & 0xffff0000u)};
                        b[m][bj][1] = (f32x4){__uint_as_float(r.z << 16), __uint_as_float(r.z & 0xffff0000u), __uint_as_float(r.w << 16), __uint_as_float(r.w & 0xffff0000u)}; } } }
            asm volatile("" ::: "memory");
#pragma unroll
            for (int m = 0; m < 4; ++m) { const int row = u.pm * BM + ai * HALF + wr * 64 + m * 16 + fr; const size_t off = (size_t)row * 1024 + col0; f32x2 q2 = {0.f, 0.f};
#pragma unroll
                for (int bj = 0; bj < 2; ++bj) { const f32x4 v0 = acc[ai][bj][m][0] + b[m][bj][0], v1 = acc[ai][bj][m][1] + b[m][bj][1];
                    if (OUT_F32) { *(f32x4*)((float*)out + off + bj * HALF) = v0; *(f32x4*)((float*)out + off + bj * HALF + 4) = v1; }
                    else *(u32x4*)((bf16_t*)out + off + bj * HALF) = pack8(v0, v1);
                    const f32x2 p0 = {v0[0], v0[1]}, p1 = {v0[2], v0[3]}, p2 = {v1[0], v1[1]}, p3 = {v1[2], v1[3]};
                    q2 = p0 * p0 + q2; q2 = p1 * p1 + q2; q2 = p2 * p2 + q2; q2 = p3 * p3 + q2; }
                float s = q2.x + q2.y;
                s += __shfl_xor(s, 16); s += __shfl_xor(s, 32);
                if (fq == 0) ss[(size_t)row * 16 + u.pn * 4 + wc] = s; }
        }
    }
};
struct EpiGateUp {
    static constexpr bool PERM = true, AFTER_DRAIN = false;
    RstdCache rc; bf16_t* H;
    __device__ __forceinline__ void operator()(const f32x4 (&acc)[2][2][4][2], const Unit& u, int wr, int wc, int fr, int fq) const {
        const int col = u.pn * HALF + wc * 32 + 8 * fq;
        rc.prepare(u.pm, wr, fq * 16 + fr);
#pragma unroll
        for (int ai = 0; ai < 2; ++ai)
#pragma unroll
            for (int m = 0; m < 4; ++m) { const int row = u.pm * BM + ai * HALF + wr * 64 + m * 16 + fr; const float rs = rc.get(ai, m, fr), c1 = -1.4426950408889634f * rs, c2 = rs * rs;
                u32x4 w;
#pragma unroll
                for (int n = 0; n < 2; ++n)
#pragma unroll
                    for (int p = 0; p < 2; ++p) { const f32x2 g = {acc[ai][0][m][n][2 * p], acc[ai][0][m][n][2 * p + 1]}, up = {acc[ai][1][m][n][2 * p], acc[ai][1][m][n][2 * p + 1]};
                        const f32x2 t = g * c1; f32x2 e; e.x = __builtin_amdgcn_exp2f(t.x); e.y = __builtin_amdgcn_exp2f(t.y);
                        const f32x2 d = e + 1.0f; f32x2 r; r.x = __builtin_amdgcn_rcpf(d.x); r.y = __builtin_amdgcn_rcpf(d.y);
                        const f32x2 h = ((g * up) * c2) * r;
                        w[2 * n + p] = cvt_pk_bf16(h.x, h.y); }
                *(u32x4*)(H + (size_t)row * 2816 + col) = w; }
    }
};
struct EpiInB {
    static constexpr bool PERM = true, AFTER_DRAIN = false;
    RstdCache rc; bf16_t *U, *QM; size_t ugv_stride; float* ssv;
    __device__ __forceinline__ void operator()(const f32x4 (&acc)[2][2][4][2], const Unit& u, int wr, int wc, int fr, int fq) const {
        const int t = u.pn / 3, pl = u.pn - 3 * t, colt = pl * BM + wc * 32 + 8 * fq;
        bf16_t* dst = t == 2 ? QM : U + (size_t)t * ugv_stride; const int ld = t == 2 ? 256 : 768;
        rc.prepare(u.pm, wr, fq * 16 + fr);
#pragma unroll
        for (int ai = 0; ai < 2; ++ai)
#pragma unroll
            for (int m = 0; m < 4; ++m) { const int row = u.pm * BM + ai * HALF + wr * 64 + m * 16 + fr; const float rs = rc.get(ai, m, fr); float s = 0.f;
#pragma unroll
                for (int bj = 0; bj < 2; ++bj) { f32x4 v0 = acc[ai][bj][m][0] * rs, v1 = acc[ai][bj][m][1] * rs;
                    if (t < 2) {
                        f32x2 q2 = {0.f, 0.f};
#pragma unroll
                        for (int p = 0; p < 4; ++p) { f32x2 x; if (p < 2) { x.x = v0[2 * p]; x.y = v0[2 * p + 1]; } else { x.x = v1[2 * p - 4]; x.y = v1[2 * p - 3]; }
                            const f32x2 a = x * ((x * x) * (-0.10294324f) + (-2.3022082f)); f32x2 e; e.x = __builtin_amdgcn_exp2f(a.x); e.y = __builtin_amdgcn_exp2f(a.y);
                            const f32x2 d = e + 1.0f; f32x2 r; r.x = __builtin_amdgcn_rcpf(d.x); r.y = __builtin_amdgcn_rcpf(d.y);
                            const f32x2 y = x * r; q2 = y * y + q2;
                            if (p < 2) { v0[2 * p] = y.x; v0[2 * p + 1] = y.y; } else { v1[2 * p - 4] = y.x; v1[2 * p - 3] = y.y; } }
                        s += q2.x + q2.y; }
                    *(u32x4*)(dst + (size_t)row * ld + colt + bj * HALF) = pack8(v0, v1); }
                if (t == 1) { s += __shfl_xor(s, 16); s += __shfl_xor(s, 32); if (fq == 0) ssv[(size_t)row * 12 + pl * 4 + wc] = s; } }
    }
};
template <class Epi, class Sched, bool ALIGN_EPI = false, bool SP2 = false>
__device__ __forceinline__ void gemm_phase(PG8_LAS unsigned char* lds, const Gemm g, const Sched& S, const Epi& E) {
    int tid = threadIdx.x; asm volatile("" : "+v"(tid));
    const int wid = __builtin_amdgcn_readfirstlane(tid >> 6), lane = tid & 63, wr = wid >> 2, wc = wid & 3, fr = lane & 15, fq = lane >> 4;
    const int K = g.K, nt = K / BK;
    unsigned voffA[2], voffB[2];
#pragma unroll
    for (int i = 0; i < 2; ++i) { int R, C; stage_rc(tid * 16 + i * 8192, R, C); const int Rb = Epi::PERM ? ((R & ~31) + perm32(R & 31)) : R;
        voffA[i] = (unsigned)(R * K + C) * 2u; voffB[i] = (unsigned)(Rb * K + C) * 2u; }
    const size_t kstep = (size_t)(BK * 2);
    const size_t hstep = (size_t)HALF * K * 2;
    const size_t tstep = 2 * hstep;
    const unsigned ldsw = (unsigned)wid * 1024u;
    const int aoff = lds_byte(wr * 64 + fr, fq * 8), boff = lds_byte(wc * 32 + fr, fq * 8);
#define PG8_SA(b, h) (((b) * 2 + (h)) * HTB)
#define PG8_SB(b, h) ((4 + (b) * 2 + (h)) * HTB)
#define PG8_STAGE(bufoff, gbase, voff) do { _Pragma("unroll") for (int _i = 0; _i < 2; ++_i) \
        __builtin_amdgcn_global_load_lds((const unsigned*)((const char*)(gbase) + (voff)[_i]), (PG8_LAS unsigned*)(lds + (bufoff) + ldsw + _i * 8192), 16, 0, 0); } while (0)
#define PG8_LDA(dst, b, h) do { _Pragma("unroll") for (int m = 0; m < 4; ++m) _Pragma("unroll") for (int k = 0; k < 2; ++k) dst[m][k] = *(const PG8_LAS bf16x8*)(lds + PG8_SA(b, h) + aoff + m * 2048 + k * 1024); } while (0)
#define PG8_LDB(dst, b, h) do { _Pragma("unroll") for (int n = 0; n < 2; ++n) _Pragma("unroll") for (int k = 0; k < 2; ++k) dst[n][k] = *(const PG8_LAS bf16x8*)(lds + PG8_SB(b, h) + boff + n * 2048 + k * 1024); } while (0)
#define PG8_MMA(ai, bj, At, Bt) do { __builtin_amdgcn_s_setprio(1); _Pragma("unroll") for (int m = 0; m < 4; ++m) _Pragma("unroll") for (int n = 0; n < 2; ++n) _Pragma("unroll") for (int k = 0; k < 2; ++k) \
        acc[ai][bj][m][n] = __builtin_amdgcn_mfma_f32_16x16x32_bf16(Bt[n][k], At[m][k], acc[ai][bj][m][n], 0, 0, 0); __builtin_amdgcn_s_setprio(0); } while (0)
#define PG8_WAIT_V(n) asm volatile("s_waitcnt vmcnt(" #n ")" ::: "memory")
#define PG8_WAIT_L(n) asm volatile("s_waitcnt lgkmcnt(" #n ")" ::: "memory")
#define PG8_BAR __builtin_amdgcn_s_barrier()
#define PG8_SCHED __builtin_amdgcn_sched_barrier(0)
    Unit cur, nxt; int ui = 0;
    if (!S.next(0, cur)) return;
    f32x4 acc[2][2][4][2];
#pragma unroll
    for (int a = 0; a < 2; ++a)
#pragma unroll
        for (int b = 0; b < 2; ++b)
#pragma unroll
            for (int m = 0; m < 4; ++m)
#pragma unroll
                for (int n = 0; n < 2; ++n) acc[a][b][m][n] = (f32x4){0.f, 0.f, 0.f, 0.f};
    bf16x8 At[4][2], B0[2][2], B1[2][2];
    const char* cA = (const char*)g.A + (size_t)cur.pm * tstep; const char* cB = (const char*)g.Bt + (size_t)cur.pn * tstep;
    S.a_ready(cur);
    if constexpr (SP2) {
        PG8_STAGE(PG8_SB(0, 0), cB, voffB); PG8_STAGE(PG8_SB(0, 1), cB + hstep, voffB); PG8_STAGE(PG8_SA(0, 0), cA, voffA); PG8_STAGE(PG8_SA(0, 1), cA + hstep, voffA);
        if (wr == 1) PG8_BAR;
        PG8_WAIT_V(2); PG8_BAR;
        PG8_STAGE(PG8_SB(1, 0), cB + kstep, voffB); PG8_STAGE(PG8_SA(1, 0), cA + kstep, voffA); PG8_STAGE(PG8_SB(1, 1), cB + hstep + kstep, voffB);
        PG8_WAIT_V(6); PG8_BAR;
    } else {
        PG8_STAGE(PG8_SB(0, 0), cB, voffB); PG8_STAGE(PG8_SA(0, 0), cA, voffA); PG8_STAGE(PG8_SB(0, 1), cB + hstep, voffB); PG8_STAGE(PG8_SA(0, 1), cA + hstep, voffA);
        if (wr == 1) PG8_BAR;
        PG8_WAIT_V(4); PG8_BAR;
        PG8_STAGE(PG8_SB(1, 0), cB + kstep, voffB); PG8_STAGE(PG8_SA(1, 0), cA + kstep, voffA); PG8_STAGE(PG8_SB(1, 1), cB + hstep + kstep, voffB);
        PG8_WAIT_V(6); PG8_BAR;
    }
    for (;;) {
        const bool has_next = S.next(ui + 1, nxt);
        const char* nA = has_next ? (const char*)g.A + (size_t)nxt.pm * tstep : cA; const char* nB = has_next ? (const char*)g.Bt + (size_t)nxt.pn * tstep : cB;
        for (int t = 0; t < nt; t += 2) {
            const bool last = (t == nt - 2);
            const char* a1 = cA + (size_t)(t + 1) * kstep;
            const char* a2 = last ? nA : cA + (size_t)(t + 2) * kstep; const char* b2 = last ? nB : cB + (size_t)(t + 2) * kstep;
            const char* a3 = a2 + kstep; const char* b3 = b2 + kstep;
            if (last && has_next) S.a_ready(nxt);
            if constexpr (SP2) {
            PG8_LDB(B0, 0, 0); PG8_LDB(B1, 0, 1); PG8_SCHED; PG8_LDA(At, 0, 0); PG8_STAGE(PG8_SA(1, 1), a1 + hstep, voffA);
            PG8_WAIT_V(8); PG8_WAIT_L(0); PG8_BAR; PG8_MMA(0, 0, At, B0); PG8_MMA(0, 1, At, B1); PG8_BAR; PG8_SCHED;
            PG8_LDA(At, 0, 1); PG8_STAGE(PG8_SB(0, 0), b2, voffB); PG8_STAGE(PG8_SB(0, 1), b2 + hstep, voffB); PG8_STAGE(PG8_SA(0, 0), a2, voffA);
            PG8_WAIT_V(8); PG8_WAIT_L(0); PG8_BAR; PG8_MMA(1, 0, At, B0); PG8_MMA(1, 1, At, B1); PG8_BAR; PG8_SCHED;
            PG8_LDB(B0, 1, 0); PG8_LDB(B1, 1, 1); PG8_SCHED; PG8_LDA(At, 1, 0); PG8_STAGE(PG8_SA(0, 1), a2 + hstep, voffA);
            PG8_WAIT_V(8); PG8_WAIT_L(0); PG8_BAR; PG8_MMA(0, 0, At, B0); PG8_MMA(0, 1, At, B1); PG8_BAR; PG8_SCHED;
            PG8_LDA(At, 1, 1); PG8_STAGE(PG8_SB(1, 0), b3, voffB); PG8_STAGE(PG8_SB(1, 1), b3 + hstep, voffB); PG8_STAGE(PG8_SA(1, 0), a3, voffA);
            PG8_WAIT_V(8); PG8_WAIT_L(0); PG8_BAR; PG8_MMA(1, 0, At, B0); PG8_MMA(1, 1, At, B1); PG8_BAR; PG8_SCHED;
            } else {
            PG8_LDB(B0, 0, 0); PG8_SCHED; PG8_LDA(At, 0, 0); PG8_STAGE(PG8_SA(1, 1), a1 + hstep, voffA);
            PG8_WAIT_L(8); PG8_BAR; PG8_WAIT_L(0); PG8_MMA(0, 0, At, B0); PG8_BAR; PG8_SCHED;
            PG8_LDB(B1, 0, 1); PG8_STAGE(PG8_SB(0, 0), b2, voffB);
            PG8_BAR; PG8_WAIT_L(0); PG8_MMA(0, 1, At, B1); PG8_BAR;
            PG8_LDA(At, 0, 1); PG8_STAGE(PG8_SA(0, 0), a2, voffA);
            PG8_BAR; PG8_WAIT_L(0); PG8_MMA(1, 0, At, B0); PG8_BAR; PG8_SCHED;
            PG8_STAGE(PG8_SB(0, 1), b2 + hstep, voffB);
            PG8_WAIT_V(6); PG8_BAR; PG8_MMA(1, 1, At, B1); PG8_BAR;
            PG8_LDB(B0, 1, 0); PG8_SCHED; PG8_LDA(At, 1, 0); PG8_STAGE(PG8_SA(0, 1), a2 + hstep, voffA);
            PG8_WAIT_L(8); PG8_BAR; PG8_WAIT_L(0); PG8_MMA(0, 0, At, B0); PG8_BAR; PG8_SCHED;
            PG8_LDB(B1, 1, 1); PG8_STAGE(PG8_SB(1, 0), b3, voffB);
            PG8_BAR; PG8_WAIT_L(0); PG8_MMA(0, 1, At, B1); PG8_BAR;
            PG8_LDA(At, 1, 1); PG8_STAGE(PG8_SA(1, 0), a3, voffA);
            PG8_BAR; PG8_WAIT_L(0); PG8_MMA(1, 0, At, B0); PG8_BAR; PG8_SCHED;
            PG8_STAGE(PG8_SB(1, 1), b3 + hstep, voffB);
            PG8_WAIT_V(6); PG8_BAR; PG8_MMA(1, 1, At, B1); PG8_BAR;
            }
        }
        if constexpr (ALIGN_EPI) { if (wr == 0) PG8_BAR; }
        if constexpr (!Epi::AFTER_DRAIN) { E(acc, cur, wr, wc, fr, fq); S.done(cur); }
        if (!has_next) break;
#pragma unroll
        for (int a = 0; a < 2; ++a)
#pragma unroll
            for (int b = 0; b < 2; ++b)
#pragma unroll
                for (int m = 0; m < 4; ++m)
#pragma unroll
                    for (int n = 0; n < 2; ++n) acc[a][b][m][n] = (f32x4){0.f, 0.f, 0.f, 0.f};
        cur = nxt; cA = nA; cB = nB; ++ui;
        if constexpr (ALIGN_EPI) { if (wr == 1) PG8_BAR; }
    }
    PG8_WAIT_V(0);
    if constexpr (!ALIGN_EPI) { if (wr == 0) PG8_BAR; }
    PG8_BAR;
    if constexpr (Epi::AFTER_DRAIN) { E.fused(acc, cur, wr, wc, fr, fq, lds, wid, lane); S.done(cur); }
#undef PG8_SA
#undef PG8_SB
#undef PG8_STAGE
#undef PG8_LDA
#undef PG8_LDB
#undef PG8_MMA
#undef PG8_WAIT_V
#undef PG8_WAIT_L
#undef PG8_BAR
#undef PG8_SCHED
}
}
namespace mx {
#define MX_LAS __attribute__((address_space(3)))
typedef unsigned short bf16_t;
typedef short bf16x8 __attribute__((ext_vector_type(8)));
typedef short s16x4 __attribute__((ext_vector_type(4)));
typedef float f32x16 __attribute__((ext_vector_type(16)));
typedef float f32x4 __attribute__((ext_vector_type(4)));
typedef unsigned u32x4 __attribute__((ext_vector_type(4)));
typedef float f32x2_t __attribute__((ext_vector_type(2))); typedef __bf16 bf16x2_t __attribute__((ext_vector_type(2)));
typedef MX_LAS unsigned char* lptr; typedef const MX_LAS unsigned char* lcptr;
#define MX_MFMA(a, b, c) __builtin_amdgcn_mfma_f32_32x32x16_bf16((a), (b), (c), 0, 0, 0)
constexpr int WAVE_LDS = 16384, KIMG = 0, VIMG = 8192;
constexpr float SB_EXIT = 9.0949470177e-13f;
__device__ __forceinline__ int crow(int r, int hi) { return (r & 3) + 8 * (r >> 2) + 4 * hi; }
__device__ __forceinline__ unsigned cvtpk(float lo, float hi) { f32x2_t v = {lo, hi}; bf16x2_t b = __builtin_convertvector(v, bf16x2_t); return __builtin_bit_cast(unsigned, b); }
__device__ __forceinline__ unsigned short f2bf(float f) { return (unsigned short)(cvtpk(f, 0.f) & 0xffffu); }
__device__ __forceinline__ float bf2f(unsigned short h) { return __uint_as_float(((unsigned)h) << 16); }
__device__ __forceinline__ s16x4 vtr(lcptr p) { typedef short v4i16_t __attribute__((ext_vector_type(4))); return __builtin_bit_cast(s16x4, __builtin_amdgcn_ds_read_tr16_b64_v4i16((MX_LAS v4i16_t*)p)); }
__device__ __forceinline__ u32x4 pk8(const f32x4 a, const f32x4 b) { u32x4 w; w.x = cvtpk(a[0], a[1]); w.y = cvtpk(a[2], a[3]); w.z = cvtpk(b[0], b[1]); w.w = cvtpk(b[2], b[3]); return w; }

template <bool DOK, bool DOV> __device__ __forceinline__ void load_tile_bf16(lptr slot, const bf16_t* Kg, const bf16_t* Vg, int pitch, int lane, int nvalid) {
    if (DOK) { const bool ok = lane < nvalid; const bf16_t* kr = Kg + (size_t)(ok ? lane : 0) * pitch; u32x4 kv[8];
#pragma unroll
        for (int c = 0; c < 8; ++c) kv[c] = *(const u32x4*)(kr + c * 8);
#pragma unroll
        for (int c = 0; c < 8; ++c) *(MX_LAS u32x4*)(slot + KIMG + c * 1024 + lane * 16) = ok ? kv[c] : (u32x4){0u, 0u, 0u, 0u}; }
    if (DOV) { u32x4 vv[8];
#pragma unroll
        for (int p = 0; p < 8; ++p) { const int row = 16 * (p & 3) + (lane >> 2); const bool ok = row < nvalid; vv[p] = *(const u32x4*)(Vg + (size_t)(ok ? row : 0) * pitch + (p >> 2) * 32 + (lane & 3) * 8); if (!ok) vv[p] = (u32x4){0u, 0u, 0u, 0u}; }
#pragma unroll
        for (int p = 0; p < 8; ++p) *(MX_LAS u32x4*)(slot + VIMG + p * 1024 + lane * 16) = vv[p]; }
}
__device__ __forceinline__ void load_tile_f32(lptr slot, const float* Kg, const float* Vg, int pitch, int lane) {
    { const float* kr = Kg + (size_t)lane * pitch;
#pragma unroll
        for (int c = 0; c < 8; ++c) { const f32x4 a = *(const f32x4*)(kr + c * 8), b = *(const f32x4*)(kr + c * 8 + 4); *(MX_LAS u32x4*)(slot + KIMG + c * 1024 + lane * 16) = pk8(a, b); } }
#pragma unroll
    for (int p = 0; p < 8; ++p) { const float* vr = Vg + (size_t)(16 * (p & 3) + (lane >> 2)) * pitch + (p >> 2) * 32 + (lane & 3) * 8;
        const f32x4 a = *(const f32x4*)vr, b = *(const f32x4*)(vr + 4); *(MX_LAS u32x4*)(slot + VIMG + p * 1024 + lane * 16) = pk8(a, b); }
}
template <bool SWZ = false> __device__ __forceinline__ void qkt(f32x16& p0, f32x16& p1, lcptr slot, const bf16x8 (&qr)[4], int r32, int hi) {
    f32x16 z;
#pragma unroll
    for (int r = 0; r < 16; ++r) z[r] = 0.f;
    p0 = z; p1 = z;
#pragma unroll
    for (int d0 = 0; d0 < 4; ++d0) { const int c = 2 * d0 + hi; lcptr kb = slot + KIMG + c * 1024 + (SWZ ? ((r32 & 24) | ((r32 ^ c) & 7)) : r32) * 16;
        const bf16x8 b0 = *(const MX_LAS bf16x8*)kb, b1 = *(const MX_LAS bf16x8*)(kb + 512);
        p0 = MX_MFMA(b0, qr[d0], p0); p1 = MX_MFMA(b1, qr[d0], p1); }
}
__device__ __forceinline__ void pv(f32x16 (&o)[2], lcptr slot, const f32x16& p0, const f32x16& p1, int lane, int hi) {
    lcptr vp = slot + VIMG + ((lane >> 4) & 1) * 32 + (lane & 3) * 8 + (4 * hi + ((lane & 15) >> 2)) * 64;
    u32x4 pw[4];
    pw[0] = (u32x4){cvtpk(p0[0], p0[1]), cvtpk(p0[2], p0[3]), cvtpk(p0[4], p0[5]), cvtpk(p0[6], p0[7])};
    pw[1] = (u32x4){cvtpk(p0[8], p0[9]), cvtpk(p0[10], p0[11]), cvtpk(p0[12], p0[13]), cvtpk(p0[14], p0[15])};
    pw[2] = (u32x4){cvtpk(p1[0], p1[1]), cvtpk(p1[2], p1[3]), cvtpk(p1[4], p1[5]), cvtpk(p1[6], p1[7])};
    pw[3] = (u32x4){cvtpk(p1[8], p1[9]), cvtpk(p1[10], p1[11]), cvtpk(p1[12], p1[13]), cvtpk(p1[14], p1[15])};
#pragma unroll
    for (int d0 = 0; d0 < 2; ++d0)
#pragma unroll
        for (int ks = 0; ks < 4; ++ks) { const s16x4 lo = vtr(vp + d0 * 4096 + ks * 1024), hh = vtr(vp + d0 * 4096 + ks * 1024 + 512);
            const bf16x8 vf = (bf16x8){lo[0], lo[1], lo[2], lo[3], hh[0], hh[1], hh[2], hh[3]};
            o[d0] = MX_MFMA(__builtin_bit_cast(bf16x8, pw[ks]), vf, o[d0]); }
}
template <bool MASK> __device__ __forceinline__ void sb_half(f32x16& p, float& S, int hi, int kbase, int qrel) {
    float k[16];
#pragma unroll
    for (int r = 0; r < 16; ++r) { const float z = __builtin_amdgcn_fmed3f(p[r], -126.f, 126.f), e = __builtin_amdgcn_exp2f(-z);   float bt = __builtin_amdgcn_rcpf(1.0f + e), kp = e * bt;
        if (MASK) { if (kbase + crow(r, hi) >= qrel) { bt = 0.f; kp = 1.f; } } p[r] = bt; k[r] = kp; }
    float GE[4], GO[4];
#pragma unroll
    for (int i = 0; i < 4; ++i) { const float g = (k[4 * i] * k[4 * i + 1]) * (k[4 * i + 2] * k[4 * i + 3]);
        auto rr = __builtin_amdgcn_permlane32_swap(__float_as_uint(g), __float_as_uint(g), false, false); GE[i] = __uint_as_float(rr[0]); GO[i] = __uint_as_float(rr[1]); }
    float own[4];
#pragma unroll
    for (int i = 3; i >= 0; --i) { const float So = S; S = S * GO[i]; const float Se = S; S = S * GE[i]; own[i] = hi ? So : Se; }
#pragma unroll
    for (int i = 0; i < 4; ++i) { float rest = own[i]; const float a3 = p[4 * i + 3] * rest; rest *= k[4 * i + 3]; const float a2 = p[4 * i + 2] * rest; rest *= k[4 * i + 2]; const float a1 = p[4 * i + 1] * rest; rest *= k[4 * i + 1];
        const float a0 = p[4 * i] * rest; p[4 * i] = a0; p[4 * i + 1] = a1; p[4 * i + 2] = a2; p[4 * i + 3] = a3; }
}
template <bool MASK, bool SWZ = false> __device__ __forceinline__ void sb_tile(f32x16 (&o)[2], float& carry, lcptr slot, const bf16x8 (&qr)[4], int lane, int r32, int hi, int qrel) {
    f32x16 p0, p1; qkt<SWZ>(p0, p1, slot, qr, r32, hi);
    sb_half<MASK>(p1, carry, hi, 32, qrel);
    sb_half<MASK>(p0, carry, hi, 0, qrel);
    pv(o, slot, p0, p1, lane, hi);
}
__device__ __forceinline__ void store_o(const f32x16 (&o)[2], bf16_t* OM, size_t row0, int col0, int r32, int hi, int nrows) {
#pragma unroll
    for (int r = 0; r < 16; ++r) { const int q = crow(r, hi); if (q < nrows) { bf16_t* p = OM + (row0 + q) * 1024 + col0 + r32; p[0] = f2bf(o[0][r]); p[32] = f2bf(o[1][r]); } }
}
__device__ __forceinline__ void store_o_staged(const f32x16 (&o)[2], lptr stg, bf16_t* OM, size_t row0, int col0, int lane, int nrows) {
    const int r32 = lane & 31, hi = lane >> 5;
#pragma unroll
    for (int r = 0; r < 16; ++r) { const int q = crow(r, hi); *(MX_LAS bf16_t*)(stg + (q * 64 + r32) * 2) = f2bf(o[0][r]); *(MX_LAS bf16_t*)(stg + (q * 64 + 32 + r32) * 2) = f2bf(o[1][r]); }
#pragma unroll
    for (int i = 0; i < 4; ++i) { const int row = i * 8 + (lane >> 3), ch = lane & 7; const u32x4 v = *(const MX_LAS u32x4*)(stg + (row * 64 + ch * 8) * 2);
        if (row < nrows) *(u32x4*)(OM + (row0 + row) * 1024 + col0 + ch * 8) = v;
        asm volatile("" ::: "memory"); }
}
struct SbArgs { const bf16_t *Q, *K, *V; const float *cK, *cV; bf16_t* OM; };
__device__ __forceinline__ void sb_sample_unit(const SbArgs& A, lptr slot, int b, int h, int lane) {
    asm volatile("" : "+v"(lane));
    const int r32 = lane & 31, hi = lane >> 5, qi = r32 & 15; const size_t row0 = (size_t)pg8::MP + b * 16;
    bf16x8 qr[4]; { const bf16_t* qp = A.Q + (row0 + qi) * 768 + h * 64 + hi * 8;
#pragma unroll
        for (int d0 = 0; d0 < 4; ++d0) qr[d0] = *(const bf16x8*)(qp + d0 * 16); }
    f32x16 o[2];
#pragma unroll
    for (int r = 0; r < 16; ++r) { o[0][r] = 0.f; o[1][r] = 0.f; }
    float carry = 1.0f;
    { const size_t toff = row0 * 768 + h * 64; load_tile_bf16<true, true>(slot, A.K + toff, A.V + toff, 768, lane, 16);
      sb_tile<true>(o, carry, slot, qr, lane, r32, hi, qi); }
    for (int T = 63; T >= 0; --T) {
        if (__all(carry < SB_EXIT)) break;
        const size_t toff = ((size_t)b * 4096 + 64 * T) * 768 + h * 64;
        load_tile_f32(slot, A.cK + toff, A.cV + toff, 768, lane);
        sb_tile<false>(o, carry, slot, qr, lane, r32, hi, 0);
    }
    store_o(o, A.OM, row0, h * 64, r32, hi, 16);
}
constexpr int SB_WIN = 5;
struct SbPre { u32x4 k[SB_WIN], v[SB_WIN]; };
__device__ __forceinline__ void sb_prefetch(SbPre& P, const SbArgs& A, int u, int tid) {
    const int bh = u >> 4, qb = u & 15, b = bh / 12, h = bh - 12 * b, Tlo = qb == 0 ? 0 : 4 * qb - (SB_WIN - 4), nt = qb == 0 ? 4 : SB_WIN;
    const size_t base = ((size_t)b * 4096 + (tid >> 3)) * 768 + h * 64 + (tid & 7) * 8;
#pragma unroll
    for (int s = 0; s < SB_WIN; ++s) { const int T = Tlo + (s < nt ? s : nt - 1); const size_t off = base + (size_t)T * 64 * 768; P.k[s] = *(const u32x4*)(A.K + off); P.v[s] = *(const u32x4*)(A.V + off); }
}
__device__ __forceinline__ void sb_stage_piece(lptr slot, const u32x4 kk, const u32x4 vv, int tid) {
    const int row = tid >> 3, c = tid & 7;
    *(MX_LAS u32x4*)(slot + KIMG + c * 1024 + ((row & 56) | ((row ^ c) & 7)) * 16) = kk;
    *(MX_LAS u32x4*)(slot + VIMG + (c >> 2) * 4096 + row * 64 + (c & 3) * 16) = vv;
}
__device__ __forceinline__ void sb_wg_units(const SbArgs& A, lptr lds, int u0, int u1, int tid) {
    asm volatile("" : "+v"(tid));
    const int lane = tid & 63, wave = __builtin_amdgcn_readfirstlane(tid >> 6), r32 = lane & 31, hi = lane >> 5;
    if (u0 >= u1) return;
    MX_LAS unsigned* flags = (MX_LAS unsigned*)(lds + SB_WIN * WAVE_LDS);
    SbPre P; sb_prefetch(P, A, u0, tid);
    for (int u = u0; u < u1; ++u) {
        const int bh = u >> 4, qb = u & 15, b = bh / 12, h = bh - 12 * b, Tlo = qb == 0 ? 0 : 4 * qb - (SB_WIN - 4);
        __syncthreads();
#pragma unroll
        for (int s = 0; s < SB_WIN; ++s) sb_stage_piece(lds + s * WAVE_LDS, P.k[s], P.v[s], tid);
        __syncthreads();
        const size_t rowq = (size_t)b * 4096 + 256 * qb + 32 * wave;
        bf16x8 qr[4]; { const bf16_t* qp = A.Q + (rowq + r32) * 768 + h * 64 + hi * 8;
#pragma unroll
            for (int d0 = 0; d0 < 4; ++d0) qr[d0] = *(const bf16x8*)(qp + d0 * 16); }
        asm volatile("" ::: "memory");
        sb_prefetch(P, A, u + 1 < u1 ? u + 1 : u, tid);
        f32x16 o[2];
#pragma unroll
        for (int r = 0; r < 16; ++r) { o[0][r] = 0.f; o[1][r] = 0.f; }
        float carry = 1.0f; const int Td = 4 * qb + (wave >> 1); bool done = false;
        for (int T = Td; T >= Tlo; --T) {
            lcptr slot = lds + (T - Tlo) * WAVE_LDS;
            if (T == Td) sb_tile<true, true>(o, carry, slot, qr, lane, r32, hi, 32 * (wave & 1) + r32); else sb_tile<false, true>(o, carry, slot, qr, lane, r32, hi, 0);
            if (__all(carry < SB_EXIT)) { done = true; break; }
        }
        for (int T = Tlo - 1; ; --T) {
            const bool need = !done && T >= 0;
            if (lane == 0) flags[wave] = need ? 1u : 0u;
            __syncthreads();
            unsigned any = 0u;
#pragma unroll
            for (int w = 0; w < 8; ++w) any |= flags[w];
            if (!__builtin_amdgcn_readfirstlane(any)) break;
            { const size_t off = ((size_t)b * 4096 + (size_t)T * 64 + (tid >> 3)) * 768 + h * 64 + (tid & 7) * 8; sb_stage_piece(lds, *(const u32x4*)(A.K + off), *(const u32x4*)(A.V + off), tid); }
            __syncthreads();
            if (need) { sb_tile<false, true>(o, carry, lds, qr, lane, r32, hi, 0); if (__all(carry < SB_EXIT)) done = true; }
        }
        store_o(o, A.OM, rowq, h * 64, r32, hi, 32);
    }
    __syncthreads();
}
struct MaArgs { const bf16_t *QM, *MK, *MV; bf16_t* OM; };
__device__ __forceinline__ void ma_wg_unit(const MaArgs& A, lptr lds, size_t row0, int bb, int mh, int nblk, int nrows, int tid) {
    asm volatile("" : "+v"(tid));
    const int lane = tid & 63, wave = __builtin_amdgcn_readfirstlane(tid >> 6), r32 = lane & 31, hi = lane >> 5;
    { const bf16_t* Kb = A.MK + (size_t)bb * 65536 + mh * 64; const bf16_t* Vb = A.MV + (size_t)bb * 65536 + mh * 64; u32x4 kv[4], vv[4];
#pragma unroll
      for (int i = 0; i < 4; ++i) { const int idx = tid + 512 * i, row = idx >> 3; kv[i] = *(const u32x4*)(Kb + (size_t)row * 256 + (idx & 7) * 8); vv[i] = *(const u32x4*)(Vb + (size_t)row * 256 + (idx & 7) * 8); }
#pragma unroll
      for (int i = 0; i < 4; ++i) { const int idx = tid + 512 * i, row = idx >> 3, c = idx & 7, rr = row & 63;
          *(MX_LAS u32x4*)(lds + (row >> 6) * WAVE_LDS + KIMG + c * 1024 + ((rr & 56) | ((rr ^ c) & 7)) * 16) = kv[i];
          *(MX_LAS u32x4*)(lds + (row >> 6) * WAVE_LDS + VIMG + (c >> 2) * 4096 + rr * 64 + (c & 3) * 16) = vv[i]; } }
    __syncthreads();
    for (int blk = wave; blk < nblk; blk += 8) {
        const size_t rowq = row0 + 32 * blk; const int qi = nrows >= 32 ? r32 : (r32 & 15);
        bf16x8 qr[4]; { const bf16_t* qp = A.QM + (rowq + qi) * 256 + mh * 64 + hi * 8;
#pragma unroll
            for (int d0 = 0; d0 < 4; ++d0) qr[d0] = *(const bf16x8*)(qp + d0 * 16); }
        float m = -INFINITY;
        for (int T = 0; T < 4; ++T) { f32x16 p0, p1; qkt<true>(p0, p1, lds + T * WAVE_LDS, qr, r32, hi);
#pragma unroll
            for (int r = 0; r < 16; ++r) m = __builtin_fmaxf(m, __builtin_fmaxf(p0[r], p1[r])); }
        { auto rr = __builtin_amdgcn_permlane32_swap(__float_as_uint(m), __float_as_uint(m), false, false); m = __builtin_fmaxf(__uint_as_float(rr[0]), __uint_as_float(rr[1])); }
        float l = 0.f; f32x16 o[2];
#pragma unroll
        for (int r = 0; r < 16; ++r) { o[0][r] = 0.f; o[1][r] = 0.f; }
        for (int T = 0; T < 4; ++T) { f32x16 p0, p1; qkt<true>(p0, p1, lds + T * WAVE_LDS, qr, r32, hi);
#pragma unroll
            for (int r = 0; r < 16; ++r) { p0[r] = __builtin_amdgcn_exp2f(p0[r] - m); p1[r] = __builtin_amdgcn_exp2f(p1[r] - m); l += p0[r] + p1[r]; }
            pv(o, lds + T * WAVE_LDS, p0, p1, lane, hi); }
        { auto rr = __builtin_amdgcn_permlane32_swap(__float_as_uint(l), __float_as_uint(l), false, false); l = __uint_as_float(rr[0]) + __uint_as_float(rr[1]); }
        { MX_LAS float* sc = (MX_LAS float*)(lds + 4 * WAVE_LDS) + wave * 32; if (hi == 0) sc[r32] = 1.0f / l;
#pragma unroll
          for (int r = 0; r < 16; ++r) { const float f = sc[crow(r, hi)]; o[0][r] *= f; o[1][r] *= f; } }
        store_o_staged(o, lds + 4 * WAVE_LDS + 1024 + wave * 4096, A.OM, rowq, 768 + mh * 64, lane, nrows);
    }
    __syncthreads();
}
struct SgArgs { const bf16_t *U, *GV, *WSP; const float *ssv, *g_sgu, *b_sp; bf16_t* OM; float* vout; int gsh_p, ch0, gsh_s, s0; };
constexpr int SG_W = 0, SG_V = 32768, SG_U = 49152, SG_O = 65536, SG_LDS = 81920;
typedef unsigned sg_u32x2 __attribute__((ext_vector_type(2)));
struct SgPre { u32x4 raw[2], uraw[2]; f32x4 sv[2][3]; f32x4 gd[4]; float bias; };
__device__ __forceinline__ void sg_decode(const SgArgs& A, int u, bool sample, int& g, size_t& row0) { const int sh = sample ? A.gsh_s : A.gsh_p, c = u & ((1 << sh) - 1); g = u >> sh; row0 = sample ? (size_t)pg8::MP + 16 * (A.s0 + c) : (size_t)(A.ch0 + c) * 128; }
__device__ __forceinline__ void sg_prefetch(SgPre& P, const SgArgs& A, int u, bool sample, int tid) {
    int g; size_t row0; sg_decode(A, u, sample, g, row0); const int nrows = sample ? 16 : 128;
#pragma unroll
    for (int i = 0; i < 2; ++i) { const int idx = tid + 512 * i, s = idx >> 3, c = idx & 7; const size_t row = row0 + (s < nrows ? s : 0);
        P.raw[i] = *(const u32x4*)(A.GV + row * 768 + g * 64 + c * 8); P.uraw[i] = *(const u32x4*)(A.U + row * 768 + g * 64 + c * 8); const f32x4* sp = (const f32x4*)(A.ssv + row * 12);
#pragma unroll
        for (int j = 0; j < 3; ++j) P.sv[i][j] = sp[j]; }
    { const int lane = tid & 63, wave = tid >> 6, t = 32 * (wave >> 1) + (lane & 31); const bool tok = t < nrows; const size_t row = row0 + (tok ? t : 0);
      const float* gp = A.g_sgu + g * 64 + 32 * (wave & 1) + 4 * (lane >> 5);
#pragma unroll
      for (int i = 0; i < 4; ++i) P.gd[i] = *(const f32x4*)(gp + 8 * i);
      P.bias = A.b_sp[g * 128 + (tok ? t : 0)]; }
}
__device__ __forceinline__ void sg_restage_w(const SgArgs& A, lptr lds, int g, int tid, int npieces) {
    const bf16_t* wg = A.WSP + (size_t)g * 16384; u32x4 w[4];
#pragma unroll
    for (int i = 0; i < 4; ++i) w[i] = *(const u32x4*)(wg + (tid + 512 * (i < npieces ? i : 0)) * 8);
#pragma unroll
    for (int i = 0; i < 4; ++i) if (i < npieces) { const int idx = tid + 512 * i, t = idx >> 4, c = idx & 15; *(MX_LAS u32x4*)(lds + SG_W + t * 256 + ((c ^ (t & 15)) * 16)) = w[i]; }
}
struct SgState { int gcur; int have_prev; size_t prow0; int pg; int pnrows; };
__device__ __forceinline__ void sg_store_out(const SgState& S, const SgArgs& A, lptr lds, int tid) {
#pragma unroll
    for (int i = 0; i < 2; ++i) { const int idx = tid + 512 * i, s = idx >> 3, c = idx & 7;
        if (s < S.pnrows) *(u32x4*)(A.OM + (S.prow0 + s) * 1024 + S.pg * 64 + c * 8) = *(const MX_LAS u32x4*)(lds + SG_O + s * 128 + ((c ^ ((s >> 1) & 7)) * 16)); }
}
template <bool CHECK_G> __device__ __forceinline__ void sg_unit_body(SgPre& P, SgState& S, const SgArgs& A, lptr lds, int u, int u1, bool sample, int tid, int lane, int wave) {
    const int r32 = lane & 31, hi = lane >> 5, tb = wave >> 1, dh = wave & 1, nrows = sample ? 16 : 128;
    int g; size_t row0; sg_decode(A, u, sample, g, row0);
    __syncthreads();
    if (S.have_prev) sg_store_out(S, A, lds, tid);
    if (CHECK_G && g != S.gcur) { S.gcur = g;
        sg_restage_w(A, lds, g, tid, sample ? 1 : 4); }
#pragma unroll
    for (int i = 0; i < 2; ++i) { const int idx = tid + 512 * i, s = idx >> 3, c = idx & 7; const u32x4 raw = P.raw[i];
        float ssum = 0.f;
#pragma unroll
        for (int j = 0; j < 3; ++j) { const f32x4 v = P.sv[i][j]; ssum += (v[0] + v[1]) + (v[2] + v[3]); }
        const float rs = s < nrows ? __builtin_amdgcn_rsqf(ssum * (1.0f / 768.0f) + pg8::RMS_EPS) : 0.f;
        f32x4 a, b2; a[0] = __uint_as_float(raw.x << 16); a[1] = __uint_as_float(raw.x & 0xffff0000u); a[2] = __uint_as_float(raw.y << 16); a[3] = __uint_as_float(raw.y & 0xffff0000u);
        b2[0] = __uint_as_float(raw.z << 16); b2[1] = __uint_as_float(raw.z & 0xffff0000u); b2[2] = __uint_as_float(raw.w << 16); b2[3] = __uint_as_float(raw.w & 0xffff0000u);
        a = a * rs; b2 = b2 * rs;
        *(MX_LAS u32x4*)(lds + SG_V + (c >> 2) * 8192 + s * 64 + (c & 3) * 16) = pk8(a, b2);
        *(MX_LAS u32x4*)(lds + SG_U + s * 128 + ((c ^ ((s >> 1) & 7)) * 16)) = P.uraw[i];
        if (sample && s < nrows) { const float* gp = A.g_sgu + g * 64 + c * 8; const f32x4 ga = *(const f32x4*)gp, gb = *(const f32x4*)(gp + 4);
            float* vo = A.vout + ((row0 - pg8::MP) + s) * 768 + g * 64 + c * 8; *(f32x4*)vo = a * ga; *(f32x4*)(vo + 4) = b2 * gb; } }
    __syncthreads();
    const f32x4 (&gd)[4] = P.gd; const float bias = P.bias;
    if (32 * tb < nrows) {
        const int t = 32 * tb + r32;
        f32x16 acc;
#pragma unroll
        for (int r = 0; r < 16; ++r) acc[r] = 0.f;
        lcptr wp = lds + SG_W + t * 256; lcptr vp = lds + SG_V + dh * 8192 + ((lane >> 4) & 1) * 32 + (lane & 3) * 8 + (8 * hi + ((lane & 15) >> 2)) * 64;
        const int nks = sample ? 1 : 2 * tb + 2;
        for (int ks = 0; ks < nks; ++ks) { const bf16x8 wa = *(const MX_LAS bf16x8*)(wp + (((2 * ks + hi) ^ (t & 15)) * 16));
            const s16x4 lo = vtr(vp + ks * 1024), hh = vtr(vp + ks * 1024 + 256);
            const bf16x8 vf = (bf16x8){lo[0], lo[1], lo[2], lo[3], hh[0], hh[1], hh[2], hh[3]};
            acc = MX_MFMA(vf, wa, acc); }
        {
#pragma unroll
            for (int i = 0; i < 4; ++i) { const int off = t * 128 + (((4 * dh + i) ^ ((t >> 1) & 7)) * 16) + 8 * hi; const sg_u32x2 uu = *(const MX_LAS sg_u32x2*)(lds + SG_U + off);
                const float u0f = __uint_as_float(uu.x << 16), u1f = __uint_as_float(uu.x & 0xffff0000u), u2f = __uint_as_float(uu.y << 16), u3f = __uint_as_float(uu.y & 0xffff0000u);
                sg_u32x2 w; w.x = cvtpk(u0f * (gd[i][0] * acc[4 * i] + bias), u1f * (gd[i][1] * acc[4 * i + 1] + bias)); w.y = cvtpk(u2f * (gd[i][2] * acc[4 * i + 2] + bias), u3f * (gd[i][3] * acc[4 * i + 3] + bias));
                *(MX_LAS sg_u32x2*)(lds + SG_O + off) = w; } }
    }
    S.have_prev = 1; S.prow0 = row0; S.pg = g; S.pnrows = nrows;
    sg_prefetch(P, A, u + 2 < u1 ? u + 2 : u1 - 1, sample, tid);
}
__device__ __forceinline__ void sg_wg_units(const SgArgs& A, lptr lds, int u0, int u1, bool sample, int tid) {
    asm volatile("" : "+v"(tid));
    const int lane = tid & 63, wave = __builtin_amdgcn_readfirstlane(tid >> 6);
    if (u0 >= u1) return;
    SgState S; S.gcur = -1; S.have_prev = 0; S.prow0 = 0; S.pg = 0; S.pnrows = 0;
    const int gshift = sample ? A.gsh_s : A.gsh_p;
    bool even = ((u1 - u0) & 1) == 0;
    for (int g = u0 >> gshift; even && (g << gshift) < u1; ++g) { const int a = (g << gshift) > u0 ? (g << gshift) : u0, b = ((g + 1) << gshift) < u1 ? ((g + 1) << gshift) : u1; if ((b - a) & 1) even = false; }
    if (even) {
        SgPre PA, PB; sg_prefetch(PA, A, u0, sample, tid); sg_prefetch(PB, A, u0 + 1, sample, tid);
        int u = u0;
        while (u < u1) {
            const int g = u >> gshift; int se = (g + 1) << gshift; if (se > u1) se = u1;
            __syncthreads();
            sg_restage_w(A, lds, g, tid, 4);
            for (; u < se; u += 2) { sg_unit_body<false>(PA, S, A, lds, u, u1, sample, tid, lane, wave); sg_unit_body<false>(PB, S, A, lds, u + 1, u1, sample, tid, lane, wave); }
        }
    } else {
        SgPre P;
        for (int u = u0; u < u1; ++u) { sg_prefetch(P, A, u, sample, tid); sg_unit_body<true>(P, S, A, lds, u, u1, sample, tid, lane, wave); }
    }
    __syncthreads();
    if (S.have_prev) sg_store_out(S, A, lds, tid);
    __syncthreads();
}
#undef MX_MFMA
}
namespace sk {
using mx::bf16_t; using mx::bf16x8; using mx::f32x16; using mx::f32x4; using mx::u32x4; using mx::cvtpk;
typedef unsigned u32x2 __attribute__((ext_vector_type(2)));
constexpr int MP = 32768;
__device__ __forceinline__ float rstd16(const float* ss, int row) { return pg8::row_rstd<16>(ss, row, 1.0f / 1024.0f); }
#define SK_GROUP(a, i) (f32x4){a[4 * (i)], a[4 * (i) + 1], a[4 * (i) + 2], a[4 * (i) + 3]}
__device__ __forceinline__ void sk_pin(float& x) { asm volatile("" : "+v"(x)); }
__device__ __forceinline__ void sk_pin(f32x4& x) { asm volatile("" : "+v"(x)); }
__device__ __forceinline__ u32x2 pk4(const f32x4 v) { u32x2 w; w.x = cvtpk(v[0], v[1]); w.y = cvtpk(v[2], v[3]); return w; }
struct SkInA {
    const float* ss; bf16_t *Q, *QM; size_t qkv_stride; float *kout_s, *vout_s;
    __device__ __forceinline__ void wrows(int cu, int& r0, int& r1) const { r0 = 64 * cu; r1 = 64 * cu + 32; }
    typedef float Pre;
    static __device__ __forceinline__ void pin(Pre& p) { sk_pin(p); }
    __device__ __forceinline__ Pre pre(int tb, int cu, int r32, int hi) const { return rstd16(ss, MP + tb * 32 + r32); }
    __device__ __forceinline__ void operator()(const f32x16& a0, const f32x16& a1, int tb, int cu, int r32, int hi, const Pre& rs) const {
        const int n0 = 64 * cu, t = n0 / 768, colw = n0 - 768 * t + 4 * hi; const int tok = tb * 32 + r32, row = MP + tok;
        bf16_t* dst = (t == 3 ? QM + (size_t)row * 256 : Q + (size_t)t * qkv_stride + (size_t)row * 768) + colw;
        float* fo = (t == 1 ? kout_s : vout_s) + (size_t)tok * 768 + colw; const bool wf = (t == 1 || t == 2);
#pragma unroll
        for (int i = 0; i < 4; ++i) { const f32x4 v0 = SK_GROUP(a0, i) * rs, v1 = SK_GROUP(a1, i) * rs;
            *(u32x2*)(dst + 8 * i) = pk4(v0); *(u32x2*)(dst + 32 + 8 * i) = pk4(v1);
            if (wf) { *(f32x4*)(fo + 8 * i) = v0; *(f32x4*)(fo + 32 + 8 * i) = v1; } }
    }
};
template <bool BASE_F32, bool OUT_F32> struct SkResidT {
    const void* base_s; void* out_s; float* ss;
    __device__ __forceinline__ void wrows(int cu, int& r0, int& r1) const { r0 = 64 * cu; r1 = 64 * cu + 32; }
    struct Pre { f32x4 b0[4], b1[4]; };
    static __device__ __forceinline__ void pin(Pre& p) {
#pragma unroll
        for (int i = 0; i < 4; ++i) { sk_pin(p.b0[i]); sk_pin(p.b1[i]); } }
    __device__ __forceinline__ Pre pre(int tb, int cu, int r32, int hi) const { Pre p; const size_t off = (size_t)(tb * 32 + r32) * 1024 + 64 * cu + 4 * hi;
#pragma unroll
        for (int i = 0; i < 4; ++i) {
            if (BASE_F32) { p.b0[i] = *(const f32x4*)((const float*)base_s + off + 8 * i); p.b1[i] = *(const f32x4*)((const float*)base_s + off + 32 + 8 * i); }
            else { const u32x2 r0 = *(const u32x2*)((const bf16_t*)base_s + off + 8 * i), r1 = *(const u32x2*)((const bf16_t*)base_s + off + 32 + 8 * i);
                p.b0[i] = (f32x4){__uint_as_float(r0.x << 16), __uint_as_float(r0.x & 0xffff0000u), __uint_as_float(r0.y << 16), __uint_as_float(r0.y & 0xffff0000u)};
                p.b1[i] = (f32x4){__uint_as_float(r1.x << 16), __uint_as_float(r1.x & 0xffff0000u), __uint_as_float(r1.y << 16), __uint_as_float(r1.y & 0xffff0000u)}; } }
        return p; }
    __device__ __forceinline__ void operator()(const f32x16& a0, const f32x16& a1, int tb, int cu, int r32, int hi, const Pre& P) const {
        const int tok = tb * 32 + r32; const size_t off = (size_t)tok * 1024 + 64 * cu + 4 * hi; float s = 0.f;
#pragma unroll
        for (int i = 0; i < 4; ++i) { const f32x4 v0 = SK_GROUP(a0, i) + P.b0[i], v1 = SK_GROUP(a1, i) + P.b1[i];
            if (OUT_F32) { *(f32x4*)((float*)out_s + off + 8 * i) = v0; *(f32x4*)((float*)out_s + off + 32 + 8 * i) = v1; }
            else { *(u32x2*)((bf16_t*)out_s + off + 8 * i) = pk4(v0); *(u32x2*)((bf16_t*)out_s + off + 32 + 8 * i) = pk4(v1); }
            s += (v0[0] * v0[0] + v0[1] * v0[1]) + (v0[2] * v0[2] + v0[3] * v0[3]) + (v1[0] * v1[0] + v1[1] * v1[1]) + (v1[2] * v1[2] + v1[3] * v1[3]); }
        { auto rr = __builtin_amdgcn_permlane32_swap(__float_as_uint(s), __float_as_uint(s), false, false); s = __uint_as_float(rr[0]) + __uint_as_float(rr[1]); }
        if (hi == 0) ss[(size_t)(MP + tok) * 16 + cu] = s;
    }
};
struct SkGateUp {
    const float* ss; bf16_t* H;
    __device__ __forceinline__ void wrows(int cu, int& r0, int& r1) const { r0 = 256 * (cu >> 2) + 32 * (cu & 3); r1 = r0 + 128; }
    typedef float Pre;
    static __device__ __forceinline__ void pin(Pre& p) { sk_pin(p); }
    __device__ __forceinline__ Pre pre(int tb, int cu, int r32, int hi) const { return rstd16(ss, MP + tb * 32 + r32); }
    __device__ __forceinline__ void operator()(const f32x16& a0, const f32x16& a1, int tb, int cu, int r32, int hi, const Pre& rs) const {
        const int row = MP + tb * 32 + r32; bf16_t* dst = H + (size_t)row * 2816 + 32 * cu + 4 * hi;
#pragma unroll
        for (int i = 0; i < 4; ++i) { const f32x4 g = SK_GROUP(a0, i) * rs, up = SK_GROUP(a1, i) * rs; f32x4 h;
#pragma unroll
            for (int e = 0; e < 4; ++e) h[e] = g[e] * pg8::fast_sigmoid(g[e]) * up[e];
            *(u32x2*)(dst + 8 * i) = pk4(h); }
    }
};
struct SkInB {
    const float* ss; bf16_t *U, *QM; size_t ugv_stride; float* ssv;
    __device__ __forceinline__ void wrows(int cu, int& r0, int& r1) const { r0 = 64 * cu; r1 = 64 * cu + 32; }
    typedef float Pre;
    static __device__ __forceinline__ void pin(Pre& p) { sk_pin(p); }
    __device__ __forceinline__ Pre pre(int tb, int cu, int r32, int hi) const { return rstd16(ss, MP + tb * 32 + r32); }
    __device__ __forceinline__ void operator()(const f32x16& a0, const f32x16& a1, int tb, int cu, int r32, int hi, const Pre& rs) const {
        const int n0 = 64 * cu, t = n0 / 768, colw = n0 - 768 * t + 4 * hi; const int row = MP + tb * 32 + r32;
        bf16_t* dst = (t == 2 ? QM + (size_t)row * 256 : U + (size_t)t * ugv_stride + (size_t)row * 768) + colw; float s = 0.f;
#pragma unroll
        for (int i = 0; i < 4; ++i) { f32x4 v0 = SK_GROUP(a0, i) * rs, v1 = SK_GROUP(a1, i) * rs;
            if (t < 2) {
#pragma unroll
                for (int e = 0; e < 4; ++e) { v0[e] = pg8::gelu_tanh(v0[e]); v1[e] = pg8::gelu_tanh(v1[e]); }
                s += (v0[0] * v0[0] + v0[1] * v0[1]) + (v0[2] * v0[2] + v0[3] * v0[3]) + (v1[0] * v1[0] + v1[1] * v1[1]) + (v1[2] * v1[2] + v1[3] * v1[3]); }
            *(u32x2*)(dst + 8 * i) = pk4(v0); *(u32x2*)(dst + 32 + 8 * i) = pk4(v1); }
        if (t == 1) { auto rr = __builtin_amdgcn_permlane32_swap(__float_as_uint(s), __float_as_uint(s), false, false); s = __uint_as_float(rr[0]) + __uint_as_float(rr[1]);
            if (hi == 0) ssv[(size_t)row * 12 + (n0 - 768) / 64] = s; }
    }
};
struct SkMemKV {
    const float* rsm; bf16_t *MK, *MV; float *ko, *vo; int l;
    __device__ __forceinline__ void wrows(int cu, int& r0, int& r1) const { r0 = l * 512 + 64 * cu; r1 = r0 + 32; }
    typedef float Pre;
    static __device__ __forceinline__ void pin(Pre& p) { sk_pin(p); }
    __device__ __forceinline__ Pre pre(int tb, int cu, int r32, int hi) const { return rsm[tb * 32 + r32]; }
    __device__ __forceinline__ void operator()(const f32x16& a0, const f32x16& a1, int tb, int cu, int r32, int hi, const Pre& rs) const {
        const int row = tb * 32 + r32; const bool isv = cu >= 4; const int colw = 64 * (cu & 3) + 4 * hi;
        bf16_t* dst = (isv ? MV : MK) + (size_t)l * 24 * 65536 + (size_t)row * 256 + colw; float* fo = (isv ? vo : ko) + (size_t)l * 2048 * 256 + (size_t)row * 256 + colw;
#pragma unroll
        for (int i = 0; i < 4; ++i) { const f32x4 v0 = SK_GROUP(a0, i) * rs, v1 = SK_GROUP(a1, i) * rs;
            *(u32x2*)(dst + 8 * i) = pk4(v0); *(u32x2*)(dst + 32 + 8 * i) = pk4(v1); *(f32x4*)(fo + 8 * i) = v0; *(f32x4*)(fo + 32 + 8 * i) = v1; }
    }
};
template <class Epi> __device__ __forceinline__ void skinny_phase(MX_LAS unsigned char* lds, const bf16_t* X, const bf16_t* Wt, int K, int ncu, const Epi& E, int ntb = 8, int wg0 = 0) {
    int tid = threadIdx.x; asm volatile("" : "+v"(tid));
    const int wave = __builtin_amdgcn_readfirstlane(tid >> 6), lane = tid & 63, r32 = lane & 31, hi = lane >> 5;
    MX_LAS float* red = (MX_LAS float*)lds;
    const int kper = K >> 3, nst = kper >> 4;
    if ((int)blockIdx.x < wg0) return;
    for (int u = blockIdx.x - wg0; u < ntb * ncu; u += gridDim.x - wg0) {
        const int tb = u % ntb, cu = u / ntb; int wr0, wr1; E.wrows(cu, wr0, wr1);
        const bf16_t* xp = X + (size_t)(tb * 32 + r32) * K + wave * kper + hi * 8;
        const bf16_t* w0 = Wt + (size_t)(wr0 + r32) * K + wave * kper + hi * 8; const bf16_t* w1 = Wt + (size_t)(wr1 + r32) * K + wave * kper + hi * 8;
        typename Epi::Pre pre = {}; if (wave == 0) pre = E.pre(tb, cu, r32, hi);
        f32x16 a0, a1;
#pragma unroll
        for (int r = 0; r < 16; ++r) { a0[r] = 0.f; a1[r] = 0.f; }
#pragma unroll 8
        for (int s = 0; s < nst; ++s) { const bf16x8 xf = *(const bf16x8*)(xp + 16 * s), f0 = *(const bf16x8*)(w0 + 16 * s), f1 = *(const bf16x8*)(w1 + 16 * s);
            a0 = __builtin_amdgcn_mfma_f32_32x32x16_bf16(f0, xf, a0, 0, 0, 0); a1 = __builtin_amdgcn_mfma_f32_32x32x16_bf16(f1, xf, a1, 0, 0, 0); }
#pragma unroll
        for (int r = 0; r < 16; ++r) { red[(wave * 32 + r) * 64 + lane] = a0[r]; red[(wave * 32 + 16 + r) * 64 + lane] = a1[r]; }
        __syncthreads();
        {
            MX_LAS float* fin = red + 8 * 32 * 64;
#pragma unroll
            for (int j = 0; j < 4; ++j) { const int reg = 4 * wave + j; float s0 = 0.f;
#pragma unroll
                for (int w = 0; w < 8; ++w) s0 += red[(w * 32 + reg) * 64 + lane];
                fin[reg * 64 + lane] = s0; }
        }
        __syncthreads();
        if (wave == 0) {
            MX_LAS const float* fin = red + 8 * 32 * 64;
#pragma unroll
            for (int r = 0; r < 16; ++r) { a0[r] = fin[r * 64 + lane]; a1[r] = fin[(16 + r) * 64 + lane]; }
            E(a0, a1, tb, cu, r32, hi, pre);
        }
        __syncthreads();
    }
}
template <class Epi> __device__ __forceinline__ void skinny_phase_k1024(MX_LAS unsigned char* lds, const bf16_t* X, const bf16_t* Wt, int ncu, const Epi& E, int ntb, int tb0, int first, int stride) {
    int tid = threadIdx.x; asm volatile("" : "+v"(tid));
    const int wave = __builtin_amdgcn_readfirstlane(tid >> 6), lane = tid & 63, r32 = lane & 31, hi = lane >> 5;
    constexpr int K = 1024, TILE = 96 * 128;
    MX_LAS unsigned char* tile = lds + wave * TILE;
    MX_LAS float* fin = (MX_LAS float*)(lds + 8 * TILE);
    const int total = ntb * ncu; int u = first;
    if (u < 0 || u >= total) return;
    u32x4 RA[12], RB[12];
    const int lrow = lane >> 3, lc = lane & 7;
#define SK_LOAD(uu) do { const int tb_ = tb0 + (uu) % ntb, cu_ = (uu) / ntb; int r0_, r1_; E.wrows(cu_, r0_, r1_); \
        const bf16_t* px_ = X + (size_t)(tb_ * 32 + lrow) * K + wave * 128 + lc * 8; const bf16_t* p0_ = Wt + (size_t)(r0_ + lrow) * K + wave * 128 + lc * 8; const bf16_t* p1_ = Wt + (size_t)(r1_ + lrow) * K + wave * 128 + lc * 8; \
        _Pragma("unroll") for (int j_ = 0; j_ < 4; ++j_) { RA[j_] = *(const u32x4*)(px_ + (size_t)j_ * 8 * K); RA[4 + j_] = *(const u32x4*)(p0_ + (size_t)j_ * 8 * K); RA[8 + j_] = *(const u32x4*)(p1_ + (size_t)j_ * 8 * K); \
                                                            RB[j_] = *(const u32x4*)(px_ + (size_t)j_ * 8 * K + 64); RB[4 + j_] = *(const u32x4*)(p0_ + (size_t)j_ * 8 * K + 64); RB[8 + j_] = *(const u32x4*)(p1_ + (size_t)j_ * 8 * K + 64); } } while (0)
#define SK_STAGE(R) do { _Pragma("unroll") for (int j_ = 0; j_ < 12; ++j_) { const int row_ = 8 * j_ + lrow; *(MX_LAS u32x4*)(tile + row_ * 128 + ((lc ^ ((row_ >> 1) & 7)) * 16)) = R[j_]; } } while (0)
#define SK_MMA() do { _Pragma("unroll") for (int s_ = 0; s_ < 4; ++s_) { const int sl_ = ((2 * s_ + hi) ^ ((r32 >> 1) & 7)) * 16; \
        const bf16x8 xf_ = *(const MX_LAS bf16x8*)(tile + r32 * 128 + sl_), f0_ = *(const MX_LAS bf16x8*)(tile + (32 + r32) * 128 + sl_), f1_ = *(const MX_LAS bf16x8*)(tile + (64 + r32) * 128 + sl_); \
        a0 = __builtin_amdgcn_mfma_f32_32x32x16_bf16(f0_, xf_, a0, 0, 0, 0); a1 = __builtin_amdgcn_mfma_f32_32x32x16_bf16(f1_, xf_, a1, 0, 0, 0); } } while (0)
    SK_LOAD(u);
    for (;;) {
        const int tb = tb0 + u % ntb, cu = u / ntb;
        typename Epi::Pre pre = {}; if (wave == 0) pre = E.pre(tb, cu, r32, hi);
        f32x16 a0, a1;
#pragma unroll
        for (int r = 0; r < 16; ++r) { a0[r] = 0.f; a1[r] = 0.f; }
        SK_STAGE(RA); SK_MMA();
        asm volatile("" ::: "memory");
        SK_STAGE(RB); SK_MMA();
        const int un = u + stride; const bool more = un < total;
        Epi::pin(pre);
        if (more) SK_LOAD(un);
        { MX_LAS float* red = (MX_LAS float*)tile;
#pragma unroll
          for (int r = 0; r < 16; ++r) { red[r * 64 + lane] = a0[r]; red[(16 + r) * 64 + lane] = a1[r]; } }
        __syncthreads();
        {
#pragma unroll
            for (int j = 0; j < 4; ++j) { const int reg = 4 * wave + j; float s0 = 0.f;
#pragma unroll
                for (int w = 0; w < 8; ++w) s0 += ((const MX_LAS float*)(lds + w * TILE))[reg * 64 + lane];
                fin[reg * 64 + lane] = s0; }
        }
        __syncthreads();
        if (wave == 0) {
#pragma unroll
            for (int r = 0; r < 16; ++r) { a0[r] = fin[r * 64 + lane]; a1[r] = fin[(16 + r) * 64 + lane]; }
            E(a0, a1, tb, cu, r32, hi, pre);
        }
        __syncthreads();
        if (!more) break;
        u = un;
    }
#undef SK_LOAD
#undef SK_STAGE
#undef SK_MMA
}
template <class Epi> __device__ __forceinline__ void skinny_phase_k2816(MX_LAS unsigned char* lds, const bf16_t* X, const bf16_t* Wt, int ncu, const Epi& E, int ntb, int tb0, int first, int stride) {
    int tid = threadIdx.x; asm volatile("" : "+v"(tid));
    const int wave = __builtin_amdgcn_readfirstlane(tid >> 6), lane = tid & 63, r32 = lane & 31, hi = lane >> 5;
    constexpr int K = 2816, TILE = 96 * 128;
    MX_LAS unsigned char* tile = lds + wave * TILE;
    MX_LAS float* fin = (MX_LAS float*)(lds + 8 * TILE);
    const int nch = wave < 4 ? 6 : 5, c0 = wave < 4 ? 6 * wave : 24 + 5 * (wave - 4);
    const int lrow = lane >> 3, lc = lane & 7;
    if (first < 0) return;
    for (int u = first; u < ntb * ncu; u += stride) {
        const int tb = tb0 + u % ntb, cu = u / ntb; int wr0, wr1; E.wrows(cu, wr0, wr1);
        const bf16_t* px = X + (size_t)(tb * 32 + lrow) * K + lc * 8; const bf16_t* p0 = Wt + (size_t)(wr0 + lrow) * K + lc * 8; const bf16_t* p1 = Wt + (size_t)(wr1 + lrow) * K + lc * 8;
        u32x4 RA[12], RB[12];
#define SK_LOADC(R, ci) do { const int co_ = 64 * (c0 + ((ci) < nch ? (ci) : nch - 1)); \
        _Pragma("unroll") for (int j_ = 0; j_ < 4; ++j_) { R[j_] = *(const u32x4*)(px + (size_t)j_ * 8 * K + co_); R[4 + j_] = *(const u32x4*)(p0 + (size_t)j_ * 8 * K + co_); R[8 + j_] = *(const u32x4*)(p1 + (size_t)j_ * 8 * K + co_); } } while (0)
#define SK_STAGE(R) do { _Pragma("unroll") for (int j_ = 0; j_ < 12; ++j_) { const int row_ = 8 * j_ + lrow; *(MX_LAS u32x4*)(tile + row_ * 128 + ((lc ^ ((row_ >> 1) & 7)) * 16)) = R[j_]; } } while (0)
#define SK_MMA() do { _Pragma("unroll") for (int s_ = 0; s_ < 4; ++s_) { const int sl_ = ((2 * s_ + hi) ^ ((r32 >> 1) & 7)) * 16; \
        const bf16x8 xf_ = *(const MX_LAS bf16x8*)(tile + r32 * 128 + sl_), f0_ = *(const MX_LAS bf16x8*)(tile + (32 + r32) * 128 + sl_), f1_ = *(const MX_LAS bf16x8*)(tile + (64 + r32) * 128 + sl_); \
        a0 = __builtin_amdgcn_mfma_f32_32x32x16_bf16(f0_, xf_, a0, 0, 0, 0); a1 = __builtin_amdgcn_mfma_f32_32x32x16_bf16(f1_, xf_, a1, 0, 0, 0); } } while (0)
        SK_LOADC(RA, 0); SK_LOADC(RB, 1);
        typename Epi::Pre pre = {}; if (wave == 0) pre = E.pre(tb, cu, r32, hi);
        f32x16 a0, a1;
#pragma unroll
        for (int r = 0; r < 16; ++r) { a0[r] = 0.f; a1[r] = 0.f; }
#pragma unroll
        for (int i = 0; i < 6; i += 2) {
            SK_STAGE(RA); SK_MMA(); asm volatile("" ::: "memory");
            if (i + 2 < 6) SK_LOADC(RA, i + 2);
            if (i + 1 < nch) { SK_STAGE(RB); SK_MMA(); } asm volatile("" ::: "memory");
            if (i + 3 < 6) SK_LOADC(RB, i + 3);
        }
        { MX_LAS float* red = (MX_LAS float*)tile;
#pragma unroll
          for (int r = 0; r < 16; ++r) { red[r * 64 + lane] = a0[r]; red[(16 + r) * 64 + lane] = a1[r]; } }
        __syncthreads();
        {
#pragma unroll
            for (int j = 0; j < 4; ++j) { const int reg = 4 * wave + j; float s0 = 0.f;
#pragma unroll
                for (int w = 0; w < 8; ++w) s0 += ((const MX_LAS float*)(lds + w * TILE))[reg * 64 + lane];
                fin[reg * 64 + lane] = s0; }
        }
        __syncthreads();
        if (wave == 0) {
#pragma unroll
            for (int r = 0; r < 16; ++r) { a0[r] = fin[r * 64 + lane]; a1[r] = fin[(16 + r) * 64 + lane]; }
            E(a0, a1, tb, cu, r32, hi, pre);
        }
        __syncthreads();
#undef SK_LOADC
#undef SK_STAGE
#undef SK_MMA
    }
}
#undef SK_GROUP
}
constexpr int NWAVES = 8;
constexpr int D = 1024, MP = 32768, MS = 256, MTOT = MP + MS, DFF = 2816, NMEMROWS = 2048;
constexpr float QSCALE = 0.125f * 1.4426950408889634f;
constexpr float EPS = 1e-6f;
constexpr size_t O_YP = 0, O_YS = 33554432, O_KP = 33816576, O_VP = 58982400, O_KS = 84148224, O_VS = 84344832, O_MK = 84541440, O_MV = 85590016, O_SV = 86638592, O_END = 86835200;
constexpr size_t MiB = 1u << 20;
constexpr size_t WS_CTL = 0, CTL_ZERO_BYTES = 65536;
constexpr size_t WS_WINA = 1 * MiB;
constexpr size_t WS_WINB = 6 * MiB;
constexpr size_t WS_WMKV = 10 * MiB;
constexpr size_t WS_WOUT = 12 * MiB;
constexpr size_t WS_WGU = 16 * MiB;
constexpr size_t WS_WDN = 38 * MiB;
constexpr size_t WS_WSP = 49 * MiB;
constexpr size_t WS_RSM = 50 * MiB;
constexpr size_t WS_SS = 51 * MiB;
constexpr size_t WS_SSV = 54 * MiB;
constexpr size_t WS_MB = 56 * MiB;
constexpr size_t WS_MK = 60 * MiB;
constexpr size_t WS_MV = 66 * MiB;
constexpr size_t WS_XB = 72 * MiB;
constexpr size_t WS_Q = 137 * MiB;
constexpr size_t WS_K = 186 * MiB;
constexpr size_t WS_V = 235 * MiB;
constexpr size_t WS_QM = 284 * MiB;
constexpr size_t WS_OM = 301 * MiB;
constexpr size_t WS_H = 366 * MiB;
constexpr size_t WS_END = 544 * MiB;
static_assert(WS_WINA + 2560ull * 1024 * 2 <= WS_WINB && WS_WINB + 1792ull * 1024 * 2 <= WS_WMKV && WS_WMKV + 1024ull * 1024 * 2 <= WS_WOUT && WS_WOUT + 2ull * 1024 * 1024 * 2 <= WS_WGU &&
              WS_WGU + 2ull * 5632 * 1024 * 2 <= WS_WDN && WS_WDN + 2ull * 1024 * 2816 * 2 <= WS_WSP && WS_WSP + 12ull * 128 * 128 * 2 <= WS_RSM && WS_SS + (size_t)MTOT * 64 <= WS_SSV &&
              WS_SSV + (size_t)MTOT * 48 <= WS_MB && WS_MB + 2048ull * 1024 * 2 <= WS_MK && WS_MK + 2ull * 24 * 65536 * 2 <= WS_MV && WS_MV + 2ull * 24 * 65536 * 2 <= WS_XB &&
              WS_XB + (size_t)MTOT * 1024 * 2 <= WS_Q && WS_Q + (size_t)MTOT * 768 * 2 <= WS_K && WS_K + (size_t)MTOT * 768 * 2 <= WS_V && WS_V + (size_t)MTOT * 768 * 2 <= WS_QM &&
              WS_V - WS_K == WS_K - WS_Q && WS_QM + (size_t)MTOT * 256 * 2 <= WS_OM && WS_OM + (size_t)MTOT * 1024 * 2 <= WS_H && WS_H + (size_t)MTOT * 2816 * 2 <= WS_END, "d_ws map");
constexpr int CW_BAR = 4096;
static_assert((CW_BAR + 3456) * 4 <= (int)CTL_ZERO_BYTES, "barrier words inside the memset region");
constexpr int RING_OFF = 0, RING_BYTES = 131072;
constexpr int LDSCTL_OFF = RING_BYTES, MISC_OFF = LDSCTL_OFF + 320;
constexpr int RC_OFF = RING_BYTES + 1024, RC_STRIDE = 528;
constexpr int LDS_BYTES = 147456;
static_assert(MISC_OFF + 128 <= RC_OFF && RC_OFF + 8 * RC_STRIDE <= LDS_BYTES, "LDS map");

#define GAS __attribute__((address_space(1)))
#define LAS __attribute__((address_space(3)))
typedef unsigned short bf16;
typedef unsigned v4u __attribute__((ext_vector_type(4)));
typedef float f32x4 __attribute__((ext_vector_type(4)));
#define RLX_AGENT __ATOMIC_RELAXED, __HIP_MEMORY_SCOPE_AGENT
#define LDS_WAIT() asm volatile("s_waitcnt lgkmcnt(0)" ::: "memory")
__device__ __forceinline__ unsigned pk2(float lo, float hi) { return mx::cvtpk(lo, hi); }
__device__ __forceinline__ float wave_sum(float v) {
#pragma unroll
    for (int o = 1; o < 64; o <<= 1) v += __shfl_xor(v, o);
    return v;
}

#define XB_TMO      128
#define XB_XCNT(j)  (256  + 64 * (j))
#define XB_XSUB(j)  (1280 + 64 * (j))
#define XB_XGEN(j)  (2304 + 64 * (j))
#define XB_TOP      3328
#define XB_TOPGEN   3392
#define XCD_BAR_WORDS 3456
#define XB_SPIN_CAP (1u << 18)

__device__ __forceinline__ unsigned xb_ld(unsigned* p)              { return __hip_atomic_load(p, __ATOMIC_RELAXED, __HIP_MEMORY_SCOPE_AGENT); }
__device__ __forceinline__ unsigned xb_add(unsigned* p, unsigned v) { return __hip_atomic_fetch_add(p, v, __ATOMIC_RELAXED, __HIP_MEMORY_SCOPE_AGENT); }
__device__ __forceinline__ unsigned xb_xcc_id() { return (unsigned)__builtin_amdgcn_s_getreg((3 << 11) | 20) & 0xFu; }
#define XB_SPIN(cond, bar) do { unsigned _sp = 0; while (cond) { __builtin_amdgcn_s_sleep(1); \
    if ((++_sp & 255u) == 0u) { if (xb_ld(&(bar)[XB_TMO])) break; if (_sp > XB_SPIN_CAP) { atomicAdd(&(bar)[XB_TMO], 1u); break; } } } } while (0)

struct XcdBarrier {
    unsigned* bar; unsigned x;
    volatile LAS unsigned* st;
};

__device__ __forceinline__ XcdBarrier xcd_barrier_post(unsigned* bar, volatile LAS unsigned* st) {
    XcdBarrier b; b.bar = bar; b.x = xb_xcc_id(); b.st = st;
    if (threadIdx.x == 0) st[2] = xb_add(&bar[XB_XCNT(b.x)], 1u);
    return b;
}
__device__ __forceinline__ void xcd_barrier_complete(unsigned* bar, unsigned x, unsigned& nloc, unsigned& nx) {
    const unsigned G = gridDim.x * gridDim.y * gridDim.z;
    unsigned sum, cnt, mine, sp = 0u;
    for (;;) {
        sum = 0u; cnt = 0u; mine = 0u;
#pragma unroll
        for (unsigned j = 0; j < 16; ++j) { const unsigned c = xb_ld(&bar[XB_XCNT(j)]); sum += c; cnt += (c > 0u) ? 1u : 0u; mine = (j == x) ? c : mine; }
        if (sum == G) break;
        __builtin_amdgcn_s_sleep(1);
        if ((++sp & 255u) == 0u) { if (xb_ld(&bar[XB_TMO])) break; if (sp > XB_SPIN_CAP) { atomicAdd(&bar[XB_TMO], 1u); break; } }
    }
    nloc = mine > 0u ? mine : 1u; nx = cnt > 0u ? cnt : 1u;
}

__device__ __forceinline__ void xcd_barrier(const XcdBarrier& b) {
    asm volatile("s_waitcnt vmcnt(0)" ::: "memory");
    __syncthreads();
    if (threadIdx.x == 0) {
        unsigned* bar = b.bar; asm volatile("" : "+s"(bar)); unsigned bx = b.x; asm volatile("" : "+s"(bx));
        __builtin_amdgcn_s_waitcnt(0);
        unsigned nloc = b.st[0], nx = b.st[1];
        if (nloc == 0u) { xcd_barrier_complete(bar, bx, nloc, nx); b.st[0] = nloc; b.st[1] = nx; }
        const unsigned old = xb_add(&bar[XB_XSUB(bx)], 1u);
        const unsigned gen = old / nloc;
        if (old + 1u == (gen + 1u) * nloc) {
            __builtin_amdgcn_fence(__ATOMIC_RELEASE, "agent");
            asm volatile("s_waitcnt vmcnt(0)" ::: "memory");
            const unsigned og = xb_add(&bar[XB_TOP], 1u);
            const unsigned tg = og / nx;
            if (og + 1u == (tg + 1u) * nx) xb_add(&bar[XB_TOPGEN], 1u);
            else XB_SPIN(xb_ld(&bar[XB_TOPGEN]) == tg, bar);
            __builtin_amdgcn_fence(__ATOMIC_ACQUIRE, "agent");
            xb_add(&bar[XB_XGEN(bx)], 1u);
            asm volatile("s_waitcnt vmcnt(0)" ::: "memory");
        } else {
            XB_SPIN(xb_ld(&bar[XB_XGEN(bx)]) == gen, bar);
            __builtin_amdgcn_fence(__ATOMIC_ACQUIRE, "agent");
            asm volatile("s_waitcnt vmcnt(0)" ::: "memory");
        }
    }
    __syncthreads();
}

constexpr bool MK_FORCE_GLOBAL_GROUPS = false;
__device__ __forceinline__ void xcd_group_setup(const XcdBarrier& b) {
    if (threadIdx.x == 0) {
        unsigned* bar = b.bar; const unsigned G = gridDim.x, x = b.x; unsigned cnt = 0u, ord = 0u, ok = (G % 8u == 0u) ? 1u : 0u;
#pragma unroll
        for (unsigned j = 0; j < 16; ++j) { const unsigned c = xb_ld(&bar[XB_XCNT(j)]); if (c) { ++cnt; ord += (j < x) ? 1u : 0u; if (c * 8u != G) ok = 0u; } }
        const bool local = !MK_FORCE_GLOBAL_GROUPS && ok && cnt == 8u;
        b.st[3] = local ? 1u : 0u;
        if (local) { b.st[4] = ord; b.st[5] = b.st[2]; b.st[6] = G / 8u; b.st[7] = 1u; }
        else if (G % 8u == 0u) { b.st[4] = blockIdx.x % 8u; b.st[5] = blockIdx.x / 8u; b.st[6] = G / 8u; b.st[7] = 1u; }
        else { b.st[4] = 0u; b.st[5] = blockIdx.x; b.st[6] = G; b.st[7] = 8u; }
    }
    __syncthreads();
}
__device__ __forceinline__ void grp_barrier(const XcdBarrier& b) {
    if (b.st[3] == 0u) { xcd_barrier(b); return; }
    asm volatile("s_waitcnt vmcnt(0)" ::: "memory");
    __syncthreads();
    if (threadIdx.x == 0) {
        unsigned* bar = b.bar; asm volatile("" : "+s"(bar)); unsigned bx = b.x; asm volatile("" : "+s"(bx));
        __builtin_amdgcn_s_waitcnt(0);
        const unsigned nloc = b.st[0];
        const unsigned old = xb_add(&bar[XB_XSUB(bx)], 1u);
        const unsigned gen = old / nloc;
        if (old + 1u == (gen + 1u) * nloc) xb_add(&bar[XB_XGEN(bx)], 1u);
        else XB_SPIN(xb_ld(&bar[XB_XGEN(bx)]) == gen, bar);
        __builtin_amdgcn_fence(__ATOMIC_ACQUIRE, "agent");
        asm volatile("s_waitcnt vmcnt(0)" ::: "memory");
    }
    __syncthreads();
}


struct Params {
    const float *xp, *xs, *csk, *csv, *cmk, *cmv, *memp, *g_mix, *w_in_a, *w_in_b, *w_sp, *b_sp, *g_sgu, *g_mem, *w_mem_kv, *w_out, *g_ffn, *w_gate, *w_up, *w_down, *g_final;
    float* out; unsigned char* ws;
};

template <int MODE> __device__ __forceinline__ void tr_item(const float* W, int K, int N, bf16* WT, const float* g, LAS float* scr, int item, int lane) {
    const int nblk = N / 32, kb = item / nblk, nb = item % nblk, k0 = 64 * kb, n0 = 32 * nb;
    f32x4 v[8]; float gk[8];
#pragma unroll
    for (int i = 0; i < 8; ++i) { const int kk = (lane >> 3) + 8 * i; v[i] = __builtin_nontemporal_load((const GAS f32x4*)(W + (size_t)(k0 + kk) * N + n0 + (lane & 7) * 4));        gk[i] = g ? g[k0 + kk] : 1.f; }
#pragma unroll
    for (int i = 0; i < 8; ++i) { const int kk = (lane >> 3) + 8 * i; LAS float* d = scr + kk * 33 + (lane & 7) * 4; const f32x4 w = v[i] * gk[i]; d[0] = w[0]; d[1] = w[1]; d[2] = w[2]; d[3] = w[3]; }
    LDS_WAIT(); asm volatile("" ::: "memory");
    float sc = 1.f; int dr = n0;
    if (MODE == 1) sc = (n0 < 768 || n0 >= 2304) ? QSCALE : 1.f;
    if (MODE == 2) sc = (n0 >= 1536) ? QSCALE : 1.f;
    if (MODE == 3) dr = 256 * (n0 >> 7) + (n0 & 127);
    if (MODE == 4) dr = 256 * (n0 >> 7) + 128 + (n0 & 127);
    const int c = lane & 7;
#pragma unroll
    for (int j = 0; j < 4; ++j) { const int n = (lane >> 3) + 8 * j; const LAS float* s = scr + (8 * c) * 33 + n;
        v4u o; o.x = pk2(s[0 * 33] * sc, s[1 * 33] * sc); o.y = pk2(s[2 * 33] * sc, s[3 * 33] * sc); o.z = pk2(s[4 * 33] * sc, s[5 * 33] * sc); o.w = pk2(s[6 * 33] * sc, s[7 * 33] * sc);
        *(GAS v4u*)(WT + (size_t)(dr + n) * K + k0 + 8 * c) = o; }
    LDS_WAIT(); asm volatile("" ::: "memory");
}
__device__ __forceinline__ float row_to_bf16(const float* xrow, bf16* orow, int lane) {
    const GAS f32x4* xr = (const GAS f32x4*)xrow + lane; f32x4 v[4]; float s = 0.f;
#pragma unroll
    for (int j = 0; j < 4; ++j) { v[j] = xr[64 * j]; s += (v[j].x * v[j].x + v[j].y * v[j].y) + (v[j].z * v[j].z + v[j].w * v[j].w); }
    GAS unsigned long long* o8 = (GAS unsigned long long*)orow + lane;
#pragma unroll
    for (int j = 0; j < 4; ++j) o8[64 * j] = (unsigned long long)pk2(v[j].x, v[j].y) | ((unsigned long long)pk2(v[j].z, v[j].w) << 32);
    return wave_sum(s);
}

typedef const Params __attribute__((address_space(4))) CParams;
#define ENV() CParams* q = (CParams*)__builtin_amdgcn_kernarg_segment_ptr(); asm volatile("" : "+s"(q)); unsigned char* const ws = q->ws; (void)ws; \
    int tid_ = threadIdx.x; asm volatile("" : "+v"(tid_)); const int tid = tid_, lane = tid & 63, wave = __builtin_amdgcn_readfirstlane(tid >> 6); const int G = gridDim.x, gw = blockIdx.x * NWAVES + wave, NGW = G * NWAVES; \
    (void)lane; (void)gw; (void)NGW; const int vcu = (G % 8 == 0) ? (int)(blockIdx.x % 8) * (G / 8) + (int)(blockIdx.x / 8) : (int)blockIdx.x; (void)vcu; LAS unsigned char* const lds = (LAS unsigned char*)lds_raw; LAS float* const rcs = (LAS float*)(lds + RC_OFF + wave * RC_STRIDE); (void)rcs; LAS unsigned char* const wslot = lds + RING_OFF + wave * mx::WAVE_LDS; (void)wslot
#define WSB(off) ((bf16*)(ws + (off)))
#define WSF(off) ((float*)(ws + (off)))
__global__ void __launch_bounds__(NWAVES * 64, 2) mk_fwd(Params Pdummy) {
    extern __shared__ __attribute__((aligned(16))) unsigned char lds_raw[];
    XcdBarrier bar;
    { ENV();
      for (int u = tid; u < (LDS_BYTES - LDSCTL_OFF) / 4; u += NWAVES * 64) ((LAS unsigned*)(lds + LDSCTL_OFF))[u] = 0u;
      __syncthreads();
      bar = xcd_barrier_post((unsigned*)(ws + WS_CTL) + CW_BAR, (volatile LAS unsigned*)(lds + MISC_OFF) + 8); }

    { ENV();
        bf16* WINA = WSB(WS_WINA); bf16* WINB = WSB(WS_WINB); bf16* WMKV = WSB(WS_WMKV); bf16* WOUT = WSB(WS_WOUT); bf16* WGU = WSB(WS_WGU); bf16* WDN = WSB(WS_WDN);
        LAS float* scr = (LAS float*)(lds + RING_OFF + wave * 16384);
        constexpr int I_A = 16 * 80, I_B = 16 * 56, I_M = 16 * 16, I_O = 16 * 32, I_G = 16 * 88, I_D = 44 * 32;
        constexpr int NITEMS = I_A + I_B + 2 * I_M + 2 * I_O + 4 * I_G + 2 * I_D;
        for (int it = gw; it < NITEMS; it += NGW) {
            int r = it;
            if (r < I_A) { tr_item<1>(q->w_in_a, 1024, 2560, WINA, q->g_mix, scr, r, lane); continue; } r -= I_A;
            if (r < I_B) { tr_item<2>(q->w_in_b, 1024, 1792, WINB, q->g_mix + 1024, scr, r, lane); continue; } r -= I_B;
            if (r < 2 * I_M) { const int l = r / I_M; tr_item<0>(q->w_mem_kv + (size_t)l * 1024 * 512, 1024, 512, WMKV + (size_t)l * 512 * 1024, q->g_mem + l * 1024, scr, r - l * I_M, lane); continue; } r -= 2 * I_M;
            if (r < 2 * I_O) { const int l = r / I_O; tr_item<0>(q->w_out + (size_t)l * 1024 * 1024, 1024, 1024, WOUT + (size_t)l * 1024 * 1024, nullptr, scr, r - l * I_O, lane); continue; } r -= 2 * I_O;
            if (r < 2 * I_G) { const int l = r / I_G; tr_item<3>(q->w_gate + (size_t)l * 1024 * DFF, 1024, DFF, WGU + (size_t)l * 5632 * 1024, q->g_ffn + l * 1024, scr, r - l * I_G, lane); continue; } r -= 2 * I_G;
            if (r < 2 * I_G) { const int l = r / I_G; tr_item<4>(q->w_up + (size_t)l * 1024 * DFF, 1024, DFF, WGU + (size_t)l * 5632 * 1024, q->g_ffn + l * 1024, scr, r - l * I_G, lane); continue; } r -= 2 * I_G;
            { const int l = r / I_D; tr_item<0>(q->w_down + (size_t)l * DFF * 1024, DFF, 1024, WDN + (size_t)l * 1024 * DFF, nullptr, scr, r - l * I_D, lane); }
        }
        { bf16* XB = WSB(WS_XB); float* SS = WSF(WS_SS); const float* xp = q->xp; const float* xs = q->xs;
          for (int m = 4 * gw; m < MTOT; m += 4 * NGW) {
            const float* x0 = m < MP ? xp + (size_t)m * D : xs + (size_t)(m - MP) * D;
            f32x4 v[4][4]; float s[4];
#pragma unroll
            for (int k = 0; k < 4; ++k) { const GAS f32x4* r = (const GAS f32x4*)(x0 + (size_t)k * D) + lane;
#pragma unroll
                for (int j = 0; j < 4; ++j) v[k][j] = __builtin_nontemporal_load(r + 64 * j); }
#pragma unroll
            for (int k = 0; k < 4; ++k) { float t = 0.f;
#pragma unroll
                for (int j = 0; j < 4; ++j) t += (v[k][j].x * v[k][j].x + v[k][j].y * v[k][j].y) + (v[k][j].z * v[k][j].z + v[k][j].w * v[k][j].w);
                GAS unsigned long long* o = (GAS unsigned long long*)(XB + (size_t)(m + k) * D) + lane;
#pragma unroll
                for (int j = 0; j < 4; ++j) o[64 * j] = (unsigned long long)pk2(v[k][j].x, v[k][j].y) | ((unsigned long long)pk2(v[k][j].z, v[k][j].w) << 32);
                s[k] = wave_sum(t); }
            { const int k = lane >> 4; const float sk = k == 0 ? s[0] : k == 1 ? s[1] : k == 2 ? s[2] : s[3]; SS[(size_t)m * 16 + lane] = (lane & 15) == 0 ? sk : 0.f; } } }
        { bf16* MB = WSB(WS_MB); float* RSM = WSF(WS_RSM); const float* memp = q->memp;
          for (int m = gw; m < NMEMROWS; m += NGW) { const float s = row_to_bf16(memp + (size_t)m * D, MB + (size_t)m * D, lane); if (lane == 0) RSM[m] = __builtin_amdgcn_rsqf(s * (1.0f / 1024.0f) + EPS); } }
        { const float* cmk = q->cmk; const float* cmv = q->cmv; bf16* MKB = WSB(WS_MK); bf16* MVB = WSB(WS_MV);
          for (int it = blockIdx.x * 512 + tid; it < 2 * 262144; it += G * 512) { const int which = it / 262144, e = it % 262144, l = e / 131072, rem = e % 131072;
            const float* src = (which ? cmv : cmk) + (size_t)l * 1048576 + (size_t)rem * 8; bf16* dst = (which ? MVB : MKB) + (size_t)l * 24 * 65536 + 8 * 65536 + (size_t)rem * 8;
            const f32x4 a = *(const f32x4*)src, b = *(const f32x4*)(src + 4); *(v4u*)dst = mx::pk8(a, b); } }
        { const float* wsp = q->w_sp; bf16* WSPB = WSB(WS_WSP);
          for (int it = blockIdx.x * 512 + tid; it < 24576; it += G * 512) { const int t = (it % 2048) / 16, s0 = (it % 16) * 8; const float* src = wsp + (size_t)it * 8;
            f32x4 a = *(const f32x4*)src, b = *(const f32x4*)(src + 4);
#pragma unroll
            for (int e = 0; e < 4; ++e) { if (s0 + e > t) a[e] = 0.f; if (s0 + 4 + e > t) b[e] = 0.f; }
            *(v4u*)(WSPB + (size_t)it * 8) = mx::pk8(a, b); } }
    }
    xcd_barrier(bar);
    xcd_group_setup(bar);
#define GENV() volatile LAS unsigned* gst_ = (volatile LAS unsigned*)(lds + MISC_OFF) + 8; const int grp = __builtin_amdgcn_readfirstlane((int)gst_[4]), rank = __builtin_amdgcn_readfirstlane((int)gst_[5]), \
    GS = __builtin_amdgcn_readfirstlane((int)gst_[6]), nb = __builtin_amdgcn_readfirstlane((int)gst_[7]); (void)grp; (void)rank; (void)GS; (void)nb

    { ENV(); GENV();
        const bool early = rank & 1;
#define P1_SMALL() do { { sk::SkMemKV E{WSF(WS_RSM), WSB(WS_MK), WSB(WS_MV), q->out + O_MK, q->out + O_MV, 0}; sk::skinny_phase_k1024(lds + RING_OFF, WSB(WS_MB), WSB(WS_WMKV), 8, E, 8 * nb, 8 * nb * grp, rank, GS); } \
          { sk::SkInA E{WSF(WS_SS), WSB(WS_Q), WSB(WS_QM), (WS_K - WS_Q) / 2, q->out + O_KS, q->out + O_VS}; sk::skinny_phase_k1024(lds + RING_OFF, WSB(WS_XB) + (size_t)MP * D, WSB(WS_WINA), 40, E, nb, nb * grp, rank, GS); } } while (0)
        if (early) { P1_SMALL(); __syncthreads(); }
        { pg8::Gemm g{WSB(WS_XB), WSB(WS_WINA), MP, 2560, 1024}; pg8::LocalOrder S; S.init(16 * nb * grp, 16 * nb, 2560, GS, rank, (grp & 1) ? 5 : 0);
          rcs[128] = __int_as_float(-1); pg8::EpiInA E{pg8::RstdCache{rcs, WSF(WS_SS)}, WSB(WS_Q), WSB(WS_QM), (WS_K - WS_Q) / 2, q->out + O_KP, q->out + O_VP};
          pg8::gemm_phase<pg8::EpiInA, pg8::LocalOrder, true, true>(lds + RING_OFF, g, S, E); }
        __syncthreads();
        if (!early) P1_SMALL();
#undef P1_SMALL
    }
    grp_barrier(bar);

    for (int l = 0; l < 2; ++l) {
        if (l == 0) { ENV(); GENV();
            const mx::SbArgs SA{WSB(WS_Q), WSB(WS_K), WSB(WS_V), q->csk, q->csv, WSB(WS_OM)};
            for (int r = rank * NWAVES + wave; r < 24 * nb; r += GS * NWAVES) mx::sb_sample_unit(SA, wslot, 2 * nb * grp + r / 12, r % 12, lane);
            __syncthreads();
            { const int tot = 192 * nb, per = (tot + GS - 1) / GS, k0 = rank * per, k1 = k0 + per < tot ? k0 + per : tot; mx::sb_wg_units(SA, lds + RING_OFF, tot * grp + k0, tot * grp + k1, tid); }
        } else { ENV(); GENV();
            const int lgnb = nb == 1 ? 0 : 3;
            const mx::SgArgs GA{WSB(WS_Q), WSB(WS_K), WSB(WS_WSP), WSF(WS_SSV), q->g_sgu, q->b_sp, WSB(WS_OM), q->out + O_SV, 5 + lgnb, 32 * nb * grp, 1 + lgnb, 2 * nb * grp};
            { const int tot = 384 * nb, per = (tot + GS - 1) / GS, k0 = rank * per, k1 = k0 + per < tot ? k0 + per : tot; mx::sg_wg_units(GA, lds + RING_OFF, k0, k1, false, tid); }
            for (int u = rank; u < 24 * nb; u += GS) mx::sg_wg_units(GA, lds + RING_OFF, u, u + 1, true, tid);
        }
        __syncthreads();
        { ENV(); GENV();
            const mx::MaArgs MA{WSB(WS_QM), WSB(WS_MK) + (size_t)l * 24 * 65536, WSB(WS_MV) + (size_t)l * 24 * 65536, WSB(WS_OM)};
            for (int k = rank; k < 32 * nb; k += GS) { const int u = 32 * nb * grp + k, bm = u >> 3, b = bm >> 2; mx::ma_wg_unit(MA, lds + RING_OFF, (size_t)b * 4096 + (u & 7) * 512, b, bm & 3, 16, 32, tid); }
            { const int nsm = 8 * nb;
              for (int k = (GS >= nsm ? rank - (GS - nsm) : rank); k < nsm; k += GS) if (k >= 0) { const int qq = nsm * grp + k, b = qq >> 2; mx::ma_wg_unit(MA, lds + RING_OFF, (size_t)MP + 16 * b, 8 + b, qq & 3, 1, 16, tid); } }
        }
        grp_barrier(bar);
        { ENV(); GENV(); const bf16* W = WSB(WS_WOUT) + (size_t)l * 1024 * 1024; bf16* XB = WSB(WS_XB);
          const bool early = rank & 1;
#define OUT_SMALL() do { sk::SkResidT<false, false> E{XB + (size_t)MP * D, XB + (size_t)MP * D, WSF(WS_SS)}; sk::skinny_phase_k1024(lds + RING_OFF, WSB(WS_OM) + (size_t)MP * D, W, 16, E, nb, nb * grp, rank, GS); } while (0)
          if (early) { OUT_SMALL(); __syncthreads(); }
          { pg8::Gemm g{WSB(WS_OM), W, MP, 1024, 1024}; pg8::LocalOrder S; S.init(16 * nb * grp, 16 * nb, 1024, GS, rank);
            pg8::EpiResidT<false, false> E{XB, XB, WSF(WS_SS)};
            pg8::gemm_phase<pg8::EpiResidT<false, false>, pg8::LocalOrder, true, true>(lds + RING_OFF, g, S, E); }
          __syncthreads();
          if (!early) OUT_SMALL();
#undef OUT_SMALL
        }
        grp_barrier(bar);
        { ENV(); GENV(); const bf16* W = WSB(WS_WGU) + (size_t)l * 5632 * 1024;
          const bool early = rank & 1;
#define GU_SMALL() do { sk::SkGateUp E{WSF(WS_SS), WSB(WS_H)}; sk::skinny_phase_k1024(lds + RING_OFF, WSB(WS_XB) + (size_t)MP * D, W, 88, E, nb, nb * grp, rank, GS); } while (0)
          if (early) { GU_SMALL(); __syncthreads(); }
          { pg8::Gemm g{WSB(WS_XB), W, MP, 5632, 1024}; pg8::LocalOrder S; S.init(16 * nb * grp, 16 * nb, 5632, GS, rank);
            rcs[128] = __int_as_float(-1); pg8::EpiGateUp E{pg8::RstdCache{rcs, WSF(WS_SS)}, WSB(WS_H)};
            pg8::gemm_phase<pg8::EpiGateUp, pg8::LocalOrder, true, true>(lds + RING_OFF, g, S, E); }
          __syncthreads();
          if (!early) GU_SMALL();
#undef GU_SMALL
        }
        grp_barrier(bar);
        { ENV(); GENV(); const bf16* W = WSB(WS_WDN) + (size_t)l * 1024 * DFF; bf16* XB = WSB(WS_XB);
          const bool early = rank & 1;
#define DN_SMALL() do { sk::SkResidT<false, false> E{XB + (size_t)MP * D, XB + (size_t)MP * D, WSF(WS_SS)}; sk::skinny_phase_k2816(lds + RING_OFF, WSB(WS_H) + (size_t)MP * DFF, W, 16, E, nb, nb * grp, rank, GS); } while (0)
          if (early) { DN_SMALL(); __syncthreads(); }
          { pg8::Gemm g{WSB(WS_H), W, MP, 1024, DFF}; pg8::LocalOrder S; S.init(16 * nb * grp, 16 * nb, 1024, GS, rank);
            pg8::EpiResidT<false, false> E{XB, XB, WSF(WS_SS)};
            pg8::gemm_phase<pg8::EpiResidT<false, false>, pg8::LocalOrder, true, true>(lds + RING_OFF, g, S, E); }
          __syncthreads();
          if (!early) DN_SMALL();
#undef DN_SMALL
        }
        grp_barrier(bar);
        if (l == 0) {
            { ENV(); GENV();
              const int lo = GS / 2;
              { sk::SkInB E{WSF(WS_SS), WSB(WS_Q), WSB(WS_QM), (WS_K - WS_Q) / 2, WSF(WS_SSV)}; sk::skinny_phase_k1024(lds + RING_OFF, WSB(WS_XB) + (size_t)MP * D, WSB(WS_WINB), 28, E, nb, nb * grp, rank - lo, GS - lo); }
              { sk::SkMemKV E{WSF(WS_RSM), WSB(WS_MK), WSB(WS_MV), q->out + O_MK, q->out + O_MV, 1}; sk::skinny_phase_k1024(lds + RING_OFF, WSB(WS_MB), WSB(WS_WMKV), 8, E, 8 * nb, 8 * nb * grp, rank - lo, GS - lo); }
              __syncthreads();
              { pg8::Gemm g{WSB(WS_XB), WSB(WS_WINB), MP, 1792, 1024}; pg8::LocalOrder S; S.init(16 * nb * grp, 16 * nb, 1792, GS, rank);
                rcs[128] = __int_as_float(-1); pg8::EpiInB E{pg8::RstdCache{rcs, WSF(WS_SS)}, WSB(WS_Q), WSB(WS_QM), (WS_K - WS_Q) / 2, WSF(WS_SSV)};
                pg8::gemm_phase<pg8::EpiInB, pg8::LocalOrder, true, true>(lds + RING_OFF, g, S, E); } }
            grp_barrier(bar);
        }
    }
    { ENV(); GENV(); const bf16* XB = WSB(WS_XB); float* O = q->out + O_YP; const float* SS = WSF(WS_SS); const f32x4* gf = (const f32x4*)q->g_final + 2 * lane;
      const int npr = 4096 * nb, ntot = npr + 32 * nb, wstep = GS * NWAVES;
      f32x4 gv[4];
#pragma unroll
      for (int j = 0; j < 2; ++j) { gv[2 * j] = gf[128 * j]; gv[2 * j + 1] = gf[128 * j + 1]; }
      for (int i0 = rank * NWAVES + wave; i0 < ntot; i0 += 4 * wstep) {
        int mrow[4]; float ssv[4]; v4u xr[4][2];
#pragma unroll
        for (int k = 0; k < 4; ++k) { const int i = i0 + k * wstep, ic = i < ntot ? i : i0; mrow[k] = ic < npr ? npr * grp + ic : MP + 32 * nb * grp + (ic - npr);
            ssv[k] = lane < 16 ? SS[(size_t)mrow[k] * 16 + lane] : 0.f;
            const GAS v4u* xp = (const GAS v4u*)(XB + (size_t)mrow[k] * D) + lane; xr[k][0] = xp[0]; xr[k][1] = xp[64]; }
#pragma unroll
        for (int k = 0; k < 4; ++k) { float s = ssv[k];
            s += __shfl_xor(s, 1); s += __shfl_xor(s, 2); s += __shfl_xor(s, 4); s += __shfl_xor(s, 8);
            s = __shfl(s, 0);
            const float rs = __builtin_amdgcn_rsqf(s * (1.0f / 1024.0f) + EPS);
            if (i0 + k * wstep < ntot) { GAS f32x4* orow = (GAS f32x4*)(O + (size_t)mrow[k] * D) + 2 * lane;
#pragma unroll
                for (int j = 0; j < 2; ++j) { const v4u r = xr[k][j];
                    const f32x4 a = {__uint_as_float(r.x << 16), __uint_as_float(r.x & 0xffff0000u), __uint_as_float(r.y << 16), __uint_as_float(r.y & 0xffff0000u)};
                    const f32x4 b = {__uint_as_float(r.z << 16), __uint_as_float(r.z & 0xffff0000u), __uint_as_float(r.w << 16), __uint_as_float(r.w & 0xffff0000u)};
                    orow[128 * j] = a * rs * gv[2 * j]; orow[128 * j + 1] = b * rs * gv[2 * j + 1]; } } }
      } }
}

extern "C" void kernel_launch(void* const* d_in, const int* in_sizes, int n_in, void* d_out, int out_size, void* d_ws, size_t ws_size, hipStream_t stream) {
    static int grid = 0;
    if (grid == 0) {
        if (n_in != 21 || (size_t)out_size != O_END || ws_size < WS_END) { fprintf(stderr, "kernel_launch: unexpected shapes (n_in %d, out %d, ws %zu); nothing launched\n", n_in, out_size, ws_size); grid = -1; return; }
        int dev = 0, cus = 0, per_cu = 0;
        if (hipGetDevice(&dev) != hipSuccess || hipDeviceGetAttribute(&cus, hipDeviceAttributeMultiprocessorCount, dev) != hipSuccess) { grid = -1; return; }
        if (hipFuncSetAttribute((const void*)mk_fwd, hipFuncAttributeMaxDynamicSharedMemorySize, LDS_BYTES) != hipSuccess) { fprintf(stderr, "kernel_launch: hipFuncSetAttribute failed\n"); grid = -1; return; }
        if (hipOccupancyMaxActiveBlocksPerMultiprocessor(&per_cu, (const void*)mk_fwd, NWAVES * 64, LDS_BYTES) != hipSuccess || per_cu < 1) fprintf(stderr, "kernel_launch: occupancy query reports %d\n", per_cu);
        (void)hipGetLastError();
        grid = cus;
    }
    if (grid < 0) return;
    if (hipMemsetAsync((char*)d_ws + WS_CTL, 0, CTL_ZERO_BYTES, stream) != hipSuccess) return;
    Params p{};
    p.xp = (const float*)d_in[0]; p.xs = (const float*)d_in[1]; p.csk = (const float*)d_in[2]; p.csv = (const float*)d_in[3]; p.cmk = (const float*)d_in[4]; p.cmv = (const float*)d_in[5];
    p.memp = (const float*)d_in[6]; p.g_mix = (const float*)d_in[7]; p.w_in_a = (const float*)d_in[8]; p.w_in_b = (const float*)d_in[9]; p.w_sp = (const float*)d_in[10]; p.b_sp = (const float*)d_in[11];
    p.g_sgu = (const float*)d_in[12]; p.g_mem = (const float*)d_in[13]; p.w_mem_kv = (const float*)d_in[14]; p.w_out = (const float*)d_in[15]; p.g_ffn = (const float*)d_in[16];
    p.w_gate = (const float*)d_in[17]; p.w_up = (const float*)d_in[18]; p.w_down = (const float*)d_in[19]; p.g_final = (const float*)d_in[20];
    p.out = (float*)d_out; p.ws = (unsigned char*)d_ws;
    hipLaunchKernelGGL(mk_fwd, dim3(grid), dim3(NWAVES * 64), LDS_BYTES, stream, p);
    const hipError_t le = hipPeekAtLastError();
    if (le != hipSuccess) fprintf(stderr, "kernel_launch: launch failed: %s\n", hipGetErrorName(le));
}
```
